# Optimizing an MI355X kernel written in HIP

```python
import math, functools
import jax, jax.numpy as jnp
from jax import lax
import numpy as np

D_MODEL = 4096
BATCH = 1
SEQ = 8192
DEPTH = 1
DEC_BATCH = 128
DEC_SEQ = 1
PAST_LEN = 8192
PAGE_SIZE = 128

ATTN_HEADS = 32
ATTN_KV_HEADS = 8
ATTN_HEAD_DIM = 64
ATTN_GROUP = ATTN_HEADS // ATTN_KV_HEADS
ATTN_WIDTH = ATTN_HEADS * ATTN_HEAD_DIM
KV_WIDTH = ATTN_KV_HEADS * ATTN_HEAD_DIM
WINDOW = 128
ROPE_THETA = 10000.0
DN_HEADS = 16
DN_KEY_DIM = 128
DN_VALUE_DIM = 128
DN_KEY_WIDTH = DN_HEADS * DN_KEY_DIM
DN_VALUE_WIDTH = DN_HEADS * DN_VALUE_DIM
CONV_WIDTH = 4
CONV_DIM = 2 * DN_KEY_WIDTH + DN_VALUE_WIDTH
DN_CHUNK = 64
MIX_WIDTH = ATTN_WIDTH + DN_VALUE_WIDTH
ATTN_QKV_WIDTH = ATTN_WIDTH + 2 * KV_WIDTH
IN_WIDTH = ATTN_QKV_WIDTH + CONV_DIM + DN_VALUE_WIDTH + 2 * DN_HEADS
FFN_HIDDEN = ((8 * D_MODEL + 3 * 256 - 1) // (3 * 256)) * 256
DEEPNORM_ALPHA = (2 * DEPTH) ** 0.25
DEEPNORM_BETA = (8 * DEPTH) ** -0.25
LN_EPS = 1e-5
RMS_EPS = 1e-6

kernel_name = 'hymba_swa_sink_gated_deltanet_deepnorm_step'


def layer_norm(x, g, b):
    xf = x.astype(jnp.float32)
    mu = jnp.mean(xf, axis=-1, keepdims=True)
    var = jnp.mean(jnp.square(xf - mu), axis=-1, keepdims=True)
    return ((xf - mu) * lax.rsqrt(var + LN_EPS) * g + b).astype(x.dtype)


def l2_normalize(x):
    xf = x.astype(jnp.float32)
    return xf * lax.rsqrt(jnp.sum(xf * xf, axis=-1, keepdims=True) + RMS_EPS)


def rope(x, pos):
    half = x.shape[-1] // 2
    inv_freq = ROPE_THETA ** (-jnp.arange(half, dtype=jnp.float32) / half)
    ang = pos[..., None].astype(jnp.float32) * inv_freq
    cos, sin = jnp.cos(ang)[:, :, None, :], jnp.sin(ang)[:, :, None, :]
    xf = x.astype(jnp.float32)
    x1, x2 = xf[..., :half], xf[..., half:]
    return jnp.concatenate([x1 * cos - x2 * sin, x2 * cos + x1 * sin], axis=-1).astype(x.dtype)


def sink_window_attention(q, k, v, pos_q, pos_k, sinks):
    n, tq = q.shape[:2]
    qg = q.reshape(n, tq, ATTN_KV_HEADS, ATTN_GROUP, ATTN_HEAD_DIM).astype(jnp.float32)
    s = jnp.einsum('nqhgd,nshd->nhgqs', qg, k.astype(jnp.float32)) * (ATTN_HEAD_DIM ** -0.5)
    diff = pos_q[:, :, None] - pos_k[:, None, :]
    valid = (diff >= 0) & (diff < WINDOW) & (pos_k[:, None, :] >= 0)
    s = jnp.where(valid[:, None, None], s, -jnp.inf)
    sink = jnp.broadcast_to(
        sinks.reshape(ATTN_KV_HEADS, ATTN_GROUP)[None, :, :, None, None].astype(jnp.float32),
        s.shape[:-1] + (1,))
    p = jax.nn.softmax(jnp.concatenate([s, sink], axis=-1), axis=-1)[..., :-1]
    o = jnp.einsum('nhgqs,nshd->nqhgd', p, v.astype(jnp.float32))
    return o.reshape(n, tq, ATTN_WIDTH).astype(q.dtype)


def prompt_window_attention(q, k, v, sinks):
    n, t = q.shape[:2]
    nb = t // WINDOW
    qb = q.reshape(n * nb, WINDOW, ATTN_HEADS, ATTN_HEAD_DIM)

    def band(a):
        ab = a.reshape(n, nb, WINDOW, ATTN_KV_HEADS, ATTN_HEAD_DIM)
        prev = jnp.pad(ab[:, :-1], ((0, 0), (1, 0), (0, 0), (0, 0), (0, 0)))
        return jnp.concatenate([prev, ab], axis=2).reshape(n * nb, 2 * WINDOW, ATTN_KV_HEADS, ATTN_HEAD_DIM)

    pos = jnp.arange(t, dtype=jnp.int32).reshape(nb, WINDOW)
    pos_q = jnp.tile(pos, (n, 1))
    pos_k = jnp.tile(jnp.concatenate([pos - WINDOW, pos], axis=-1), (n, 1))
    out = sink_window_attention(qb, band(k), band(v), pos_q, pos_k, sinks).reshape(n, t, ATTN_WIDTH)
    return out, k[:, -WINDOW:], v[:, -WINDOW:]


def sample_window_attention(q, k, v, sinks, k_buf, v_buf):
    t = q.shape[1]
    lb = k_buf.shape[1]
    k_all = jnp.concatenate([k_buf, k.astype(k_buf.dtype)], axis=1)
    v_all = jnp.concatenate([v_buf, v.astype(v_buf.dtype)], axis=1)
    pos_q = (PAST_LEN + jnp.arange(t, dtype=jnp.int32))[None]
    pos_k = (PAST_LEN - lb + jnp.arange(lb + t, dtype=jnp.int32))[None]
    out = sink_window_attention(q, k_all, v_all, pos_q, pos_k, sinks)
    return out, k_all[:, -lb:], v_all[:, -lb:]


def causal_short_conv(xc, buf, w_conv):
    t = xc.shape[1]
    xp = jnp.concatenate([buf.astype(xc.dtype), xc], axis=1)
    y = sum(w_conv[j] * xp[:, j:j + t] for j in range(CONV_WIDTH))
    return jax.nn.silu(y), xp[:, -(CONV_WIDTH - 1):]


def gated_delta_rule(q, k, v, g, beta, s0, chunk):
    n, t, h, dk = q.shape
    dv = v.shape[-1]
    nc = t // chunk

    def blocks(a):
        return jnp.moveaxis(a.astype(jnp.float32).reshape((n, nc, chunk, h) + a.shape[3:]), 3, 1)

    q, k, v, g, beta = blocks(q), blocks(k), blocks(v), blocks(g), blocks(beta)
    cum = jnp.cumsum(g, axis=-1)
    idx = jnp.arange(chunk)
    causal = idx[:, None] >= idx[None, :]
    strict = idx[:, None] > idx[None, :]
    decay = jnp.exp(jnp.where(causal, cum[..., :, None] - cum[..., None, :], -jnp.inf))
    kk = jnp.einsum('nhcid,nhcjd->nhcij', k, k)
    lower = jnp.where(strict, beta[..., :, None] * kk * decay, 0.0) + jnp.eye(chunk, dtype=jnp.float32)
    gamma = jnp.exp(cum)
    rhs = jnp.concatenate([k * (beta * gamma)[..., None], v * beta[..., None]], axis=-1)
    sol = lax.linalg.triangular_solve(lower, rhs, left_side=True, lower=True, unit_diagonal=True)
    w, u = sol[..., :dk], sol[..., dk:]
    att = jnp.einsum('nhcid,nhcjd->nhcij', q, k) * decay
    q_dec = q * gamma[..., None]
    k_dec = k * jnp.exp(cum[..., -1:] - cum)[..., None]
    g_last = jnp.exp(cum[..., -1])

    def step(s, xs):
        w_c, u_c, att_c, q_c, k_c, gl_c = xs
        u_new = u_c - jnp.einsum('nhcd,nhde->nhce', w_c, s)
        o = jnp.einsum('nhcd,nhde->nhce', q_c, s) + jnp.einsum('nhij,nhje->nhie', att_c, u_new)
        s = gl_c[..., None, None] * s + jnp.einsum('nhcd,nhce->nhde', k_c, u_new)
        return s, o

    xs = tuple(jnp.moveaxis(a, 2, 0) for a in (w, u, att, q_dec, k_dec, g_last))
    s_fin, o = lax.scan(step, s0.astype(jnp.float32), xs)
    o = jnp.transpose(o, (1, 0, 3, 2, 4)).reshape(n, t, h, dv)
    return o, s_fin.astype(s0.dtype)


def gated_deltanet(qkv_pre, z, a, b, conv_buf, s0, chunk, w_conv, dn_a_log, dn_dt_bias, dn_norm_w):
    n, t, _ = qkv_pre.shape
    qkv, conv_new = causal_short_conv(qkv_pre, conv_buf, w_conv)
    q = l2_normalize(qkv[..., :DN_KEY_WIDTH].reshape(n, t, DN_HEADS, DN_KEY_DIM)) * (DN_KEY_DIM ** -0.5)
    k = l2_normalize(qkv[..., DN_KEY_WIDTH:2 * DN_KEY_WIDTH].reshape(n, t, DN_HEADS, DN_KEY_DIM))
    v = qkv[..., 2 * DN_KEY_WIDTH:].reshape(n, t, DN_HEADS, DN_VALUE_DIM)
    g = -jnp.exp(dn_a_log.astype(jnp.float32)) * jax.nn.softplus((a + dn_dt_bias).astype(jnp.float32))
    beta = jax.nn.sigmoid(b.astype(jnp.float32))
    o, s_new = gated_delta_rule(q, k, v, g, beta, s0, chunk)
    o = o * lax.rsqrt(jnp.mean(o * o, axis=-1, keepdims=True) + RMS_EPS) * dn_norm_w
    o = o * jax.nn.silu(z.reshape(n, t, DN_HEADS, DN_VALUE_DIM).astype(jnp.float32))
    return o.reshape(n, t, DN_VALUE_WIDTH).astype(qkv_pre.dtype), conv_new, s_new


def hybrid_layer(x, pos, attn_fn, conv_buf, s0, chunk, w_in, b_attn, attn_sinks, w_conv,
                 dn_a_log, dn_dt_bias, dn_norm_w, w_out, ln1_g, ln1_b,
                 w_gate, w_up, w_down, ln2_g, ln2_b):
    n, t, _ = x.shape
    proj = jnp.einsum('btd,de->bte', x, w_in)
    qkv_a = proj[..., :ATTN_QKV_WIDTH] + b_attn
    q_a = rope(qkv_a[..., :ATTN_WIDTH].reshape(n, t, ATTN_HEADS, ATTN_HEAD_DIM), pos)
    k_a = rope(qkv_a[..., ATTN_WIDTH:ATTN_WIDTH + KV_WIDTH].reshape(n, t, ATTN_KV_HEADS, ATTN_HEAD_DIM), pos)
    v_a = qkv_a[..., ATTN_WIDTH + KV_WIDTH:].reshape(n, t, ATTN_KV_HEADS, ATTN_HEAD_DIM)
    attn_out, k_buf, v_buf = attn_fn(q_a, k_a, v_a, attn_sinks)
    off = ATTN_QKV_WIDTH
    qkv_pre = proj[..., off:off + CONV_DIM]
    off += CONV_DIM
    z = proj[..., off:off + DN_VALUE_WIDTH]
    off += DN_VALUE_WIDTH
    a = proj[..., off:off + DN_HEADS]
    off += DN_HEADS
    b = proj[..., off:off + DN_HEADS]
    dn_out, conv_new, s_new = gated_deltanet(qkv_pre, z, a, b, conv_buf, s0, chunk,
                                             w_conv, dn_a_log, dn_dt_bias, dn_norm_w)
    mixed = jnp.einsum('bte,ed->btd', jnp.concatenate([attn_out, dn_out], axis=-1), w_out)
    h = layer_norm(DEEPNORM_ALPHA * x + mixed, ln1_g, ln1_b)
    ffn = jax.nn.silu(jnp.einsum('btd,df->btf', h, w_gate)) * jnp.einsum('btd,df->btf', h, w_up)
    y = layer_norm(DEEPNORM_ALPHA * h + jnp.einsum('btf,fd->btd', ffn, w_down), ln2_g, ln2_b)
    return y, k_buf, v_buf, conv_new, s_new


def setup_inputs(seed: int = 0) -> dict:
    key = jax.random.key(seed)
    ks = jax.random.split(key, 24)

    def nrm(k, shape, scale):
        return jax.random.normal(k, shape, jnp.float32) * scale

    buf_len = min(WINDOW, PAST_LEN)
    dt = jnp.exp(jax.random.uniform(ks[11], (DEPTH, DN_HEADS), jnp.float32,
                                    minval=math.log(1e-3), maxval=math.log(1e-1)))
    return {
        'x_prompt': nrm(ks[0], (BATCH, SEQ, D_MODEL), 1.0),
        'x_sample': nrm(ks[1], (DEC_BATCH, DEC_SEQ, D_MODEL), 1.0),
        'cache_swa_k': nrm(ks[2], (DEPTH, DEC_BATCH, buf_len, ATTN_KV_HEADS, ATTN_HEAD_DIM), 1.0),
        'cache_swa_v': nrm(ks[3], (DEPTH, DEC_BATCH, buf_len, ATTN_KV_HEADS, ATTN_HEAD_DIM), 1.0),
        'state_conv': nrm(ks[4], (DEPTH, DEC_BATCH, CONV_WIDTH - 1, CONV_DIM), 1.0),
        'state_delta': nrm(ks[5], (DEPTH, DEC_BATCH, DN_HEADS, DN_KEY_DIM, DN_VALUE_DIM), DN_KEY_DIM ** -0.5),
        'w_in': nrm(ks[6], (DEPTH, D_MODEL, IN_WIDTH), D_MODEL ** -0.5),
        'b_attn': nrm(ks[7], (DEPTH, ATTN_QKV_WIDTH), 0.02),
        'attn_sinks': nrm(ks[8], (DEPTH, ATTN_HEADS), 0.5),
        'w_conv': nrm(ks[9], (DEPTH, CONV_WIDTH, CONV_DIM), CONV_WIDTH ** -0.5),
        'dn_a_log': jnp.log(jax.random.uniform(ks[10], (DEPTH, DN_HEADS), jnp.float32, minval=1.0, maxval=16.0)),
        'dn_dt_bias': dt + jnp.log(-jnp.expm1(-dt)),
        'dn_norm_w': 1.0 + nrm(ks[12], (DEPTH, DN_VALUE_DIM), 0.02),
        'w_out': nrm(ks[13], (DEPTH, MIX_WIDTH, D_MODEL), MIX_WIDTH ** -0.5 * DEEPNORM_BETA),
        'ln1_g': 1.0 + nrm(ks[14], (DEPTH, D_MODEL), 0.02),
        'ln1_b': nrm(ks[15], (DEPTH, D_MODEL), 0.02),
        'w_gate': nrm(ks[16], (DEPTH, D_MODEL, FFN_HIDDEN), D_MODEL ** -0.5),
        'w_up': nrm(ks[17], (DEPTH, D_MODEL, FFN_HIDDEN), D_MODEL ** -0.5),
        'w_down': nrm(ks[18], (DEPTH, FFN_HIDDEN, D_MODEL), FFN_HIDDEN ** -0.5 * DEEPNORM_BETA),
        'ln2_g': 1.0 + nrm(ks[19], (DEPTH, D_MODEL), 0.02),
        'ln2_b': nrm(ks[20], (DEPTH, D_MODEL), 0.02),
    }


def reference(x_prompt, x_sample, cache_swa_k, cache_swa_v, state_conv, state_delta,
              w_in, b_attn, attn_sinks, w_conv, dn_a_log, dn_dt_bias, dn_norm_w, w_out,
              ln1_g, ln1_b, w_gate, w_up, w_down, ln2_g, ln2_b):
    pos_prompt = jnp.arange(x_prompt.shape[1], dtype=jnp.int32)[None]
    pos_sample = (PAST_LEN + jnp.arange(x_sample.shape[1], dtype=jnp.int32))[None]
    y_p, y_s = x_prompt, x_sample
    pk, pv, pc, ps, sk, sv, sc, ss = [], [], [], [], [], [], [], []
    for l in range(DEPTH):
        lw = dict(w_in=w_in[l], b_attn=b_attn[l], attn_sinks=attn_sinks[l], w_conv=w_conv[l],
                  dn_a_log=dn_a_log[l], dn_dt_bias=dn_dt_bias[l], dn_norm_w=dn_norm_w[l],
                  w_out=w_out[l], ln1_g=ln1_g[l], ln1_b=ln1_b[l], w_gate=w_gate[l],
                  w_up=w_up[l], w_down=w_down[l], ln2_g=ln2_g[l], ln2_b=ln2_b[l])
        n_p = y_p.shape[0]
        conv0 = jnp.zeros((n_p, CONV_WIDTH - 1, CONV_DIM), y_p.dtype)
        s0 = jnp.zeros((n_p, DN_HEADS, DN_KEY_DIM, DN_VALUE_DIM), state_delta.dtype)
        y_p, k1, v1, c1, s1 = hybrid_layer(y_p, pos_prompt, prompt_window_attention,
                                           conv0, s0, DN_CHUNK, **lw)
        attn_sample = functools.partial(sample_window_attention,
                                        k_buf=cache_swa_k[l], v_buf=cache_swa_v[l])
        y_s, k2, v2, c2, s2 = hybrid_layer(y_s, pos_sample, attn_sample, state_conv[l],
                                           state_delta[l], y_s.shape[1], **lw)
        pk.append(k1); pv.append(v1); pc.append(c1); ps.append(s1)
        sk.append(k2); sv.append(v2); sc.append(c2); ss.append(s2)
    return (y_p, y_s, jnp.stack(pk), jnp.stack(pv), jnp.stack(pc), jnp.stack(ps),
            jnp.stack(sk), jnp.stack(sv), jnp.stack(sc), jnp.stack(ss))
```

```cpp
#include <hip/hip_runtime.h>
#include <cstdio>
#include <cstdint>
#include <cmath>
#define MK_N_LAUNCHES 11
namespace pg8 {
#define PG8_LAS __attribute__((address_space(3)))
typedef unsigned short bf16_t;
typedef short bf16x8 __attribute__((ext_vector_type(8)));
typedef float f32x4 __attribute__((ext_vector_type(4)));
typedef unsigned u32x4 __attribute__((ext_vector_type(4)));
constexpr int BM = 256, BK = 64, HALF = 128, HTB = HALF * BK * 2  , STAGE_BYTES = 8 * HTB, NXCD = 8, WGM = 8;

__host__ __device__ __forceinline__ int lds_byte(int r, int c) { const int st = (r >> 4) * 2 + (c >> 5), rr = r & 15, cc = c & 31, ob = rr * 64 + cc * 2; return st * 1024 + (ob ^ (((ob >> 9) & 1) << 5)); }
__host__ __device__ __forceinline__ void stage_rc(int b, int& R, int& C) { const int st = b / 1024, sb = b % 1024, swz = sb ^ (((sb >> 9) & 1) << 5); R = (st >> 1) * 16 + swz / 64; C = (st & 1) * 32 + (swz % 64) / 2; }
__host__ __device__ __forceinline__ int perm32(int rho) { const int n = rho >> 4, i = rho & 15; return 8 * (i >> 2) + 4 * n + (i & 3); }

struct Unit { int pm, pn; };
struct Gemm { const bf16_t* A; const bf16_t* Bt; int M, N, K; };

struct StaticOrder {
    int nM, nN, nwg, G, c;
    __host__ __device__ void init(int M, int N, int G_, int c_) { nM = M / BM; nN = N / BM; nwg = nM * nN; G = G_; c = c_; }
    __host__ __device__ bool next(int i, Unit& u) const {
        const long L = (long)i * G + c; if (L >= nwg) return false;
        int wgid = (int)L; { const int q = nwg / NXCD, r = nwg % NXCD, xcd = wgid % NXCD, off = wgid / NXCD; wgid = (xcd < r ? xcd * (q + 1) : r * (q + 1) + (xcd - r) * q) + off; }
        const int nig = WGM * nN, gid = wgid / nig, fm = gid * WGM, gsz = (nM - fm) < WGM ? (nM - fm) : WGM;
        u.pm = fm + ((wgid % nig) % gsz); u.pn = (wgid % nig) / gsz; return true;
    }
    __device__ __forceinline__ void a_ready(const Unit&) const {}
    __device__ __forceinline__ void done(const Unit&) const {}
};

__device__ __forceinline__ unsigned cvt_pk_bf16(float lo, float hi) { unsigned r; asm volatile("v_cvt_pk_bf16_f32 %0, %1, %2" : "=v"(r) : "v"(lo), "v"(hi)); return r; }
typedef float f32x2 __attribute__((ext_vector_type(2)));

struct EpiProj {
    static constexpr bool PERM = true, AFTER_DRAIN = false;
    bf16_t* O; int ldc; const float* bias; float* ab; int ab_pn;
    __device__ __forceinline__ void operator()(const f32x4 (&acc)[2][2][4][2], const Unit& u, int wr, int wc, int fr, int fq) const {
        const int row0 = u.pm * BM + wr * 64 + fr; const int col0 = u.pn * BM + wc * 32 + 8 * fq;
        f32x4 bv[2][2];
#pragma unroll
        for (int bj = 0; bj < 2; ++bj)
#pragma unroll
            for (int n = 0; n < 2; ++n) bv[bj][n] = *(const f32x4*)(bias + col0 + bj * HALF + 4 * n);
        const bool do_ab = (u.pn == ab_pn) && (wc == 0);
#pragma unroll
        for (int ai = 0; ai < 2; ++ai)
#pragma unroll
            for (int m = 0; m < 4; ++m) { const int row = row0 + ai * HALF + m * 16; bf16_t* rowp = O + (size_t)row * ldc + col0;
#pragma unroll
                for (int bj = 0; bj < 2; ++bj) { const f32x4 v0 = acc[ai][bj][m][0] + bv[bj][0], v1 = acc[ai][bj][m][1] + bv[bj][1];
                    u32x4 w; w.x = cvt_pk_bf16(v0[0], v0[1]); w.y = cvt_pk_bf16(v0[2], v0[3]); w.z = cvt_pk_bf16(v1[0], v1[1]); w.w = cvt_pk_bf16(v1[2], v1[3]);
                    *(u32x4*)(rowp + bj * HALF) = w;
                    if (bj == 0 && do_ab) { float* ap = ab + (size_t)row * 32 + 8 * fq; *(f32x4*)ap = v0; *(f32x4*)(ap + 4) = v1; } } }
    }
};
struct EpiRes {
    static constexpr bool PERM = false, AFTER_DRAIN = false;
    const float* res0; const float* res1; float* out0; float* out1; int split, mrows, ldc; float alpha;
    __device__ __forceinline__ void operator()(const f32x4 (&acc)[2][2][4][2], const Unit& u, int wr, int wc, int fr, int fq) const {
        const int col0 = u.pn * BM + wc * 32 + 4 * fq;
#pragma unroll
        for (int ai = 0; ai < 2; ++ai)
#pragma unroll
            for (int m = 0; m < 4; ++m) { const int row = u.pm * BM + ai * HALF + wr * 64 + m * 16 + fr;
                if (row < mrows) {
                    const float* rp = row < split ? res0 + (size_t)row * ldc : res1 + (size_t)(row - split) * ldc;
                    float* op = row < split ? out0 + (size_t)row * ldc : out1 + (size_t)(row - split) * ldc;
#pragma unroll
                    for (int bj = 0; bj < 2; ++bj)
#pragma unroll
                        for (int n = 0; n < 2; ++n) { const int c = col0 + bj * HALF + n * 16; const f32x4 r = *(const f32x4*)(rp + c); *(f32x4*)(op + c) = r * alpha + acc[ai][bj][m][n]; } } }
    }
};
struct EpiSwiGLU {
    static constexpr bool PERM = true, AFTER_DRAIN = false;
    bf16_t* O; int ldc;
    static __device__ __forceinline__ float silu_mul(float g, float uu) { return g * uu * __builtin_amdgcn_rcpf(1.0f + __builtin_amdgcn_exp2f(-1.4426950408889634f * g)); }
    __device__ __forceinline__ void operator()(const f32x4 (&acc)[2][2][4][2], const Unit& u, int wr, int wc, int fr, int fq) const {
        const int row0 = u.pm * BM + wr * 64 + fr; const int col0 = u.pn * HALF + wc * 32 + 8 * fq;
#pragma unroll
        for (int ai = 0; ai < 2; ++ai)
#pragma unroll
            for (int m = 0; m < 4; ++m) { bf16_t* rowp = O + (size_t)(row0 + ai * HALF + m * 16) * ldc + col0;
                const f32x4 g0 = acc[ai][0][m][0], g1 = acc[ai][0][m][1], u0 = acc[ai][1][m][0], u1 = acc[ai][1][m][1];
                u32x4 w; w.x = cvt_pk_bf16(silu_mul(g0[0], u0[0]), silu_mul(g0[1], u0[1])); w.y = cvt_pk_bf16(silu_mul(g0[2], u0[2]), silu_mul(g0[3], u0[3]));
                w.z = cvt_pk_bf16(silu_mul(g1[0], u1[0]), silu_mul(g1[1], u1[1])); w.w = cvt_pk_bf16(silu_mul(g1[2], u1[2]), silu_mul(g1[3], u1[3]));
                *(u32x4*)rowp = w; }
    }
};
template <class Epi, class Sched, bool ALIGN_EPI = false, bool SP2 = false>
__device__ __forceinline__ void gemm_phase(PG8_LAS unsigned char* lds, const Gemm g, const Sched& S, const Epi& E) {
    const int tid = threadIdx.x, wid = __builtin_amdgcn_readfirstlane(tid >> 6), lane = tid & 63, wr = wid >> 2, wc = wid & 3, fr = lane & 15, fq = lane >> 4;
    const int K = g.K, nt = K / BK;
    unsigned voffA[2], voffB[2];
#pragma unroll
    for (int i = 0; i < 2; ++i) { int R, C; stage_rc(tid * 16 + i * 8192, R, C); const int Rb = Epi::PERM ? ((R & ~31) + perm32(R & 31)) : R;
        voffA[i] = (unsigned)(R * K + C) * 2u; voffB[i] = (unsigned)(Rb * K + C) * 2u; }
    const size_t kstep = (size_t)(BK * 2);
    const size_t hstep = (size_t)HALF * K * 2;
    const size_t tstep = 2 * hstep;
    const unsigned ldsw = (unsigned)wid * 1024u;
    const int aoff = lds_byte(wr * 64 + fr, fq * 8), boff = lds_byte(wc * 32 + fr, fq * 8);
#define PG8_SA(b, h) (((b) * 2 + (h)) * HTB)
#define PG8_SB(b, h) ((4 + (b) * 2 + (h)) * HTB)
#define PG8_STAGE(bufoff, gbase, voff) do { _Pragma("unroll") for (int _i = 0; _i < 2; ++_i) \
        __builtin_amdgcn_global_load_lds((const unsigned*)((const char*)(gbase) + (voff)[_i]), (PG8_LAS unsigned*)(lds + (bufoff) + ldsw + _i * 8192), 16, 0, 0); } while (0)
#define PG8_LDA(dst, b, h) do { _Pragma("unroll") for (int m = 0; m < 4; ++m) _Pragma("unroll") for (int k = 0; k < 2; ++k) dst[m][k] = *(const PG8_LAS bf16x8*)(lds + PG8_SA(b, h) + aoff + m * 2048 + k * 1024); } while (0)
#define PG8_LDB(dst, b, h) do { _Pragma("unroll") for (int n = 0; n < 2; ++n) _Pragma("unroll") for (int k = 0; k < 2; ++k) dst[n][k] = *(const PG8_LAS bf16x8*)(lds + PG8_SB(b, h) + boff + n * 2048 + k * 1024); } while (0)
#define PG8_MMA(ai, bj, At, Bt) do { __builtin_amdgcn_s_setprio(1); _Pragma("unroll") for (int m = 0; m < 4; ++m) _Pragma("unroll") for (int n = 0; n < 2; ++n) _Pragma("unroll") for (int k = 0; k < 2; ++k) \
        acc[ai][bj][m][n] = __builtin_amdgcn_mfma_f32_16x16x32_bf16(Bt[n][k], At[m][k], acc[ai][bj][m][n], 0, 0, 0); __builtin_amdgcn_s_setprio(0); } while (0)
#define PG8_WAIT_V(n) asm volatile("s_waitcnt vmcnt(" #n ")" ::: "memory")
#define PG8_WAIT_L(n) asm volatile("s_waitcnt lgkmcnt(" #n ")" ::: "memory")
#define PG8_BAR __builtin_amdgcn_s_barrier()
#define PG8_SCHED __builtin_amdgcn_sched_barrier(0)
    Unit cur, nxt; int ui = 0;
    if (!S.next(0, cur)) return;
    f32x4 acc[2][2][4][2];
#pragma unroll
    for (int a = 0; a < 2; ++a)
#pragma unroll
        for (int b = 0; b < 2; ++b)
#pragma unroll
            for (int m = 0; m < 4; ++m)
#pragma unroll
                for (int n = 0; n < 2; ++n) acc[a][b][m][n] = (f32x4){0.f, 0.f, 0.f, 0.f};
    bf16x8 At[4][2], B0[2][2], B1[2][2];
    const char* cA = (const char*)g.A + (size_t)cur.pm * tstep; const char* cB = (const char*)g.Bt + (size_t)cur.pn * tstep;
    S.a_ready(cur);
    if constexpr (SP2) {
        PG8_STAGE(PG8_SB(0, 0), cB, voffB); PG8_STAGE(PG8_SB(0, 1), cB + hstep, voffB); PG8_STAGE(PG8_SA(0, 0), cA, voffA); PG8_STAGE(PG8_SA(0, 1), cA + hstep, voffA);
        if (wr == 1) PG8_BAR;
        PG8_WAIT_V(2); PG8_BAR;
        PG8_STAGE(PG8_SB(1, 0), cB + kstep, voffB); PG8_STAGE(PG8_SA(1, 0), cA + kstep, voffA); PG8_STAGE(PG8_SB(1, 1), cB + hstep + kstep, voffB);
        PG8_WAIT_V(6); PG8_BAR;
    } else {
        PG8_STAGE(PG8_SB(0, 0), cB, voffB); PG8_STAGE(PG8_SA(0, 0), cA, voffA); PG8_STAGE(PG8_SB(0, 1), cB + hstep, voffB); PG8_STAGE(PG8_SA(0, 1), cA + hstep, voffA);
        if (wr == 1) PG8_BAR;
        PG8_WAIT_V(4); PG8_BAR;
        PG8_STAGE(PG8_SB(1, 0), cB + kstep, voffB); PG8_STAGE(PG8_SA(1, 0), cA + kstep, voffA); PG8_STAGE(PG8_SB(1, 1), cB + hstep + kstep, voffB);
        PG8_WAIT_V(6); PG8_BAR;
    }
    for (;;) {
        const bool has_next = S.next(ui + 1, nxt);
        const char* nA = has_next ? (const char*)g.A + (size_t)nxt.pm * tstep : cA; const char* nB = has_next ? (const char*)g.Bt + (size_t)nxt.pn * tstep : cB;
        for (int t = 0; t < nt; t += 2) {
            const bool last = (t == nt - 2);
            const char* a1 = cA + (size_t)(t + 1) * kstep;
            const char* a2 = last ? nA : cA + (size_t)(t + 2) * kstep; const char* b2 = last ? nB : cB + (size_t)(t + 2) * kstep;
            const char* a3 = a2 + kstep; const char* b3 = b2 + kstep;
            if (last && has_next) S.a_ready(nxt);
            if constexpr (SP2) {
            PG8_LDB(B0, 0, 0); PG8_LDB(B1, 0, 1); PG8_SCHED; PG8_LDA(At, 0, 0); PG8_STAGE(PG8_SA(1, 1), a1 + hstep, voffA);
            PG8_WAIT_V(8); PG8_WAIT_L(0); PG8_BAR; PG8_MMA(0, 0, At, B0); PG8_MMA(0, 1, At, B1); PG8_BAR; PG8_SCHED;
            PG8_LDA(At, 0, 1); PG8_STAGE(PG8_SB(0, 0), b2, voffB); PG8_STAGE(PG8_SB(0, 1), b2 + hstep, voffB); PG8_STAGE(PG8_SA(0, 0), a2, voffA);
            PG8_WAIT_V(8); PG8_WAIT_L(0); PG8_BAR; PG8_MMA(1, 0, At, B0); PG8_MMA(1, 1, At, B1); PG8_BAR; PG8_SCHED;
            PG8_LDB(B0, 1, 0); PG8_LDB(B1, 1, 1); PG8_SCHED; PG8_LDA(At, 1, 0); PG8_STAGE(PG8_SA(0, 1), a2 + hstep, voffA);
            PG8_WAIT_V(8); PG8_WAIT_L(0); PG8_BAR; PG8_MMA(0, 0, At, B0); PG8_MMA(0, 1, At, B1); PG8_BAR; PG8_SCHED;
            PG8_LDA(At, 1, 1); PG8_STAGE(PG8_SB(1, 0), b3, voffB); PG8_STAGE(PG8_SB(1, 1), b3 + hstep, voffB); PG8_STAGE(PG8_SA(1, 0), a3, voffA);
            PG8_WAIT_V(8); PG8_WAIT_L(0); PG8_BAR; PG8_MMA(1, 0, At, B0); PG8_MMA(1, 1, At, B1); PG8_BAR; PG8_SCHED;
            } else {
            PG8_LDB(B0, 0, 0); PG8_SCHED; PG8_LDA(At, 0, 0); PG8_STAGE(PG8_SA(1, 1), a1 + hstep, voffA);
            PG8_WAIT_L(8); PG8_BAR; PG8_WAIT_L(0); PG8_MMA(0, 0, At, B0); PG8_BAR; PG8_SCHED;
            PG8_LDB(B1, 0, 1); PG8_STAGE(PG8_SB(0, 0), b2, voffB);
            PG8_BAR; PG8_WAIT_L(0); PG8_MMA(0, 1, At, B1); PG8_BAR;
            PG8_LDA(At, 0, 1); PG8_STAGE(PG8_SA(0, 0), a2, voffA);
            PG8_BAR; PG8_WAIT_L(0); PG8_MMA(1, 0, At, B0); PG8_BAR; PG8_SCHED;
            PG8_STAGE(PG8_SB(0, 1), b2 + hstep, voffB);
            PG8_WAIT_V(6); PG8_BAR; PG8_MMA(1, 1, At, B1); PG8_BAR;
            PG8_LDB(B0, 1, 0); PG8_SCHED; PG8_LDA(At, 1, 0); PG8_STAGE(PG8_SA(0, 1), a2 + hstep, voffA);
            PG8_WAIT_L(8); PG8_BAR; PG8_WAIT_L(0); PG8_MMA(0, 0, At, B0); PG8_BAR; PG8_SCHED;
            PG8_LDB(B1, 1, 1); PG8_STAGE(PG8_SB(1, 0), b3, voffB);
            PG8_BAR; PG8_WAIT_L(0); PG8_MMA(0, 1, At, B1); PG8_BAR;
            PG8_LDA(At, 1, 1); PG8_STAGE(PG8_SA(1, 0), a3, voffA);
            PG8_BAR; PG8_WAIT_L(0); PG8_MMA(1, 0, At, B0); PG8_BAR; PG8_SCHED;
            PG8_STAGE(PG8_SB(1, 1), b3 + hstep, voffB);
            PG8_WAIT_V(6); PG8_BAR; PG8_MMA(1, 1, At, B1); PG8_BAR;
            }
        }
        if constexpr (ALIGN_EPI) { if (wr == 0) PG8_BAR; }
        if constexpr (!Epi::AFTER_DRAIN) { E(acc, cur, wr, wc, fr, fq); S.done(cur); }
        if (!has_next) break;
#pragma unroll
        for (int a = 0; a < 2; ++a)
#pragma unroll
            for (int b = 0; b < 2; ++b)
#pragma unroll
                for (int m = 0; m < 4; ++m)
#pragma unroll
                    for (int n = 0; n < 2; ++n) acc[a][b][m][n] = (f32x4){0.f, 0.f, 0.f, 0.f};
        cur = nxt; cA = nA; cB = nB; ++ui;
        if constexpr (ALIGN_EPI) { if (wr == 1) PG8_BAR; }
    }
    PG8_WAIT_V(0);
    if constexpr (!ALIGN_EPI) { if (wr == 0) PG8_BAR; }
    PG8_BAR;
    if constexpr (Epi::AFTER_DRAIN) { E.fused(acc, cur, wr, wc, fr, fq, lds, wid, lane); S.done(cur); }
#undef PG8_SA
#undef PG8_SB
#undef PG8_STAGE
#undef PG8_LDA
#undef PG8_LDB
#undef PG8_MMA
#undef PG8_WAIT_V
#undef PG8_WAIT_L
#undef PG8_BAR
#undef PG8_SCHED
}
}

constexpr int NWAVES = 8, NTHR = NWAVES * 64;
constexpr int DM = 4096, TP = 8192, NS = 128, MROWS = TP + NS, MPAD = 8448;
constexpr int INW = 11296, INP = 11520;
constexpr int OFF_K = 2048, OFF_V = 2560, OFF_PRE = 3072, OFF_Z = 9216, OFF_AB = 11264;
constexpr int CONVD = 6144, FF = 11008, NGU = 2 * FF;
constexpr int NCHUNK = 128, NITEM = 16 * NCHUNK;
constexpr float ALPHA = 1.189207115002721f;
constexpr float LN_EPS = 1e-5f, RMS_EPS = 1e-6f, LOG2E = 1.4426950408889634f;
constexpr float QSCALE = 0.125f * LOG2E;
constexpr size_t O_Y = 0, O_PK = 34078720, O_PV = 34144256, O_PC = 34209792, O_PD = 34228224, O_SK = 34490368, O_SV = 42878976, O_SC = 51267584, O_SD = 53626880, O_END = 87181312;

constexpr size_t MiB = 1u << 20;
constexpr size_t WS_CTL = 0, CTL_ZERO_BYTES = 1 * MiB;
constexpr size_t WS_BIASP = 1 * MiB;
constexpr size_t WS_ROPE = 2 * MiB;
constexpr size_t WS_AB = 5 * MiB;
constexpr size_t WS_GB = 6 * MiB + 512 * 1024;
constexpr size_t WS_GL = 7 * MiB + 640 * 1024;
constexpr size_t WS_SQA = 8 * MiB, WS_SQD = 9 * MiB, WS_SKD = 10 * MiB, WS_SVD = 11 * MiB;
constexpr size_t WS_WOUT = 12 * MiB, WS_WGU = 44 * MiB, WS_WDN = 216 * MiB, WS_WIN = 302 * MiB;
constexpr size_t WS_QB = 302 * MiB, WS_KB = 334 * MiB;
constexpr size_t WS_XB = 392 * MiB;
constexpr size_t WS_PROJ = 458 * MiB;
constexpr size_t WS_QH = 644 * MiB, WS_KH = 676 * MiB, WS_VH = 708 * MiB;
constexpr size_t WS_ORAW = 644 * MiB;
constexpr size_t WS_CWN = 740 * MiB, WS_CQD = 772 * MiB, WS_CKD = 804 * MiB, WS_CAT = 836 * MiB, WS_CU = 852 * MiB;
constexpr size_t WS_FFN = 644 * MiB;
constexpr size_t WS_END = 916 * MiB;
static_assert(WS_WIN + (size_t)INP * DM * 2 <= WS_XB && WS_XB + (size_t)MPAD * DM * 2 <= WS_PROJ && WS_PROJ + (size_t)MPAD * INP * 2 <= WS_QH && WS_CU + (size_t)NITEM * 64 * 128 * 4 <= WS_END && WS_FFN + (size_t)MPAD * FF * 2 <= WS_END, "ws map");
static_assert(WS_WGU + (size_t)NGU * DM * 2 <= WS_WDN && WS_WDN + (size_t)DM * FF * 2 <= WS_WIN && WS_ROPE + 8193 * 32 * 8 <= WS_AB && WS_AB + (size_t)MPAD * 32 * 4 <= WS_GB && WS_GB + TP * 32 * 4 <= WS_GL, "ws map 2");
constexpr int CW_TMO = 0, CW_CODE = 1, CW_BAR = 4096, CW_QATT = 16384, CW_QSMP = 16384 + 64;

constexpr int RING_OFF = 0, RING_BYTES = 131072, LDSCTL_OFF = RING_BYTES, MISC_OFF = LDSCTL_OFF + 320, LDS_BYTES = 147456;
#define GAS __attribute__((address_space(1)))
#define LAS __attribute__((address_space(3)))
typedef unsigned short bf16;
typedef unsigned v4u __attribute__((ext_vector_type(4)));
typedef float f32x4 __attribute__((ext_vector_type(4)));
typedef short bf16x8 __attribute__((ext_vector_type(8)));
typedef GAS unsigned gu32;
typedef GAS unsigned long long gu64;
#define RLX_AGENT __ATOMIC_RELAXED, __HIP_MEMORY_SCOPE_AGENT
#define LDS_WAIT() asm volatile("s_waitcnt lgkmcnt(0)" ::: "memory")
#define VM_WAIT() asm volatile("s_waitcnt vmcnt(0)" ::: "memory")
__device__ __forceinline__ unsigned long long rt() { return __builtin_amdgcn_s_memrealtime(); }
__device__ __forceinline__ unsigned f2bf(float f) { unsigned u = __builtin_bit_cast(unsigned, f); return (u + 0x7fffu + ((u >> 16) & 1u)) >> 16; }
__device__ __forceinline__ unsigned pk2(float lo, float hi) { return f2bf(lo) | (f2bf(hi) << 16); }

#define XB_TMO      128
#define XB_XCNT(j)  (256  + 64 * (j))
#define XB_XSUB(j)  (1280 + 64 * (j))
#define XB_XGEN(j)  (2304 + 64 * (j))
#define XB_TOP      3328
#define XB_TOPGEN   3392
#define XCD_BAR_WORDS 3456
#define XB_SPIN_CAP (1u << 18)

__device__ __forceinline__ unsigned xb_ld(unsigned* p)              { return __hip_atomic_load(p, __ATOMIC_RELAXED, __HIP_MEMORY_SCOPE_AGENT); }
__device__ __forceinline__ unsigned xb_add(unsigned* p, unsigned v) { return __hip_atomic_fetch_add(p, v, __ATOMIC_RELAXED, __HIP_MEMORY_SCOPE_AGENT); }
__device__ __forceinline__ unsigned xb_xcc_id() { return (unsigned)__builtin_amdgcn_s_getreg((3 << 11) | 20) & 0xFu; }
#define XB_SPIN(cond, bar) do { unsigned _sp = 0; while (cond) { __builtin_amdgcn_s_sleep(1); \
    if ((++_sp & 255u) == 0u) { if (xb_ld(&(bar)[XB_TMO])) break; if (_sp > XB_SPIN_CAP) { atomicAdd(&(bar)[XB_TMO], 1u); break; } } } } while (0)

struct XcdBarrier {
    unsigned* bar; unsigned x;
    volatile LAS unsigned* st;
};

__device__ __forceinline__ XcdBarrier xcd_barrier_post(unsigned* bar, volatile LAS unsigned* st) {
    XcdBarrier b; b.bar = bar; b.x = xb_xcc_id(); b.st = st;
    if (threadIdx.x == 0) (void)xb_add(&bar[XB_XCNT(b.x)], 1u);
    return b;
}
__device__ __forceinline__ void xcd_barrier_complete(unsigned* bar, unsigned x, unsigned& nloc, unsigned& nx) {
    const unsigned G = gridDim.x * gridDim.y * gridDim.z;
    unsigned sum, cnt, mine, sp = 0u;
    for (;;) {
        sum = 0u; cnt = 0u; mine = 0u;
#pragma unroll
        for (unsigned j = 0; j < 16; ++j) { const unsigned c = xb_ld(&bar[XB_XCNT(j)]); sum += c; cnt += (c > 0u) ? 1u : 0u; mine = (j == x) ? c : mine; }
        if (sum == G) break;
        __builtin_amdgcn_s_sleep(1);
        if ((++sp & 255u) == 0u) { if (xb_ld(&bar[XB_TMO])) break; if (sp > XB_SPIN_CAP) { atomicAdd(&bar[XB_TMO], 1u); break; } }
    }
    nloc = mine > 0u ? mine : 1u; nx = cnt > 0u ? cnt : 1u;
}

__device__ __forceinline__ void xcd_barrier(const XcdBarrier& b) {
    asm volatile("s_waitcnt vmcnt(0)" ::: "memory");
    __syncthreads();
    if (threadIdx.x == 0) {
        unsigned* bar = b.bar;
        __builtin_amdgcn_s_waitcnt(0);
        unsigned nloc = b.st[0], nx = b.st[1];
        if (nloc == 0u) { xcd_barrier_complete(bar, b.x, nloc, nx); b.st[0] = nloc; b.st[1] = nx; }
        const unsigned old = xb_add(&bar[XB_XSUB(b.x)], 1u);
        const unsigned gen = old / nloc;
        if (old + 1u == (gen + 1u) * nloc) {
            __builtin_amdgcn_fence(__ATOMIC_RELEASE, "agent");
            asm volatile("s_waitcnt vmcnt(0)" ::: "memory");
            const unsigned og = xb_add(&bar[XB_TOP], 1u);
            const unsigned tg = og / nx;
            if (og + 1u == (tg + 1u) * nx) xb_add(&bar[XB_TOPGEN], 1u);
            else XB_SPIN(xb_ld(&bar[XB_TOPGEN]) == tg, bar);
            __builtin_amdgcn_fence(__ATOMIC_ACQUIRE, "agent");
            xb_add(&bar[XB_XGEN(b.x)], 1u);
            asm volatile("s_waitcnt vmcnt(0)" ::: "memory");
        } else {
            XB_SPIN(xb_ld(&bar[XB_XGEN(b.x)]) == gen, bar);
            __builtin_amdgcn_fence(__ATOMIC_ACQUIRE, "agent");
            asm volatile("s_waitcnt vmcnt(0)" ::: "memory");
        }
    }
    __syncthreads();
}

typedef float f32x16 __attribute__((ext_vector_type(16)));
typedef float f32x2 __attribute__((ext_vector_type(2)));
typedef unsigned v2u __attribute__((ext_vector_type(2)));
typedef __bf16 bf16x2_t __attribute__((ext_vector_type(2)));
#define DI __device__ __forceinline__
#define MFMA32(a, b, c) __builtin_amdgcn_mfma_f32_32x32x16_bf16((a), (b), (c), 0, 0, 0)
#define MFMA16(a, b, c) __builtin_amdgcn_mfma_f32_16x16x32_bf16((a), (b), (c), 0, 0, 0)
DI unsigned cvtpk(float lo, float hi) { f32x2 v = {lo, hi}; bf16x2_t b = __builtin_convertvector(v, bf16x2_t); return __builtin_bit_cast(unsigned, b); }
DI float bf2f(unsigned short b) { return __uint_as_float((unsigned)b << 16); }
DI float bflo(unsigned w) { return __uint_as_float(w << 16); }
DI float bfhi(unsigned w) { return __uint_as_float(w & 0xffff0000u); }
DI bf16x8 pack8(const f32x4& a, const f32x4& b) { v4u p; p.x = cvtpk(a[0], a[1]); p.y = cvtpk(a[2], a[3]); p.z = cvtpk(b[0], b[1]); p.w = cvtpk(b[2], b[3]); return __builtin_bit_cast(bf16x8, p); }
DI float wave_sum(float v) {
#pragma unroll
    for (int o = 1; o < 64; o <<= 1) v += __shfl_xor(v, o);
    return v;
}
DI float wave_max(float v) {
#pragma unroll
    for (int o = 1; o < 64; o <<= 1) v = fmaxf(v, __shfl_xor(v, o));
    return v;
}
DI float silu_f(float x) { return x * __builtin_amdgcn_rcpf(1.0f + __builtin_amdgcn_exp2f(-LOG2E * x)); }
DI float silu_acc(float x) { return x / (1.0f + __expf(-x)); }
DI int crow32(int r, int hl) { return (r & 3) + 8 * (r >> 2) + 4 * hl; }

__constant__ float ROPE_HI[32] = {1.591549367e-01f, 1.193493679e-01f, 8.949939907e-02f, 6.711508334e-02f, 5.032921210e-02f, 3.774158657e-02f, 2.830219641e-02f, 2.122365311e-02f, 1.591549441e-02f, 1.193493698e-02f, 8.949940093e-03f, 6.711508147e-03f, 5.032921210e-03f, 3.774158424e-03f, 2.830219688e-03f, 2.122365171e-03f, 1.591549488e-03f, 1.193493721e-03f, 8.949940093e-04f, 6.711508031e-04f, 5.032921326e-04f, 3.774158540e-04f, 2.830219455e-04f, 2.122365258e-04f, 1.591549371e-04f, 1.193493736e-04f, 8.949940093e-05f, 6.711508468e-05f, 5.032921035e-05f, 3.774158540e-05f, 2.830219637e-05f, 2.122365186e-05f};
__constant__ float ROPE_LO[32] = {6.420638243e-09f, 2.294664903e-09f, 2.542919653e-09f, -3.316028840e-10f, 5.173299289e-12f, -1.848551645e-09f, -5.826552019e-10f, -3.431038786e-10f, -1.029942312e-10f, 4.320196978e-11f, 6.802745173e-11f, 1.531042237e-10f, 5.173298855e-13f, 4.797548470e-11f, -1.048316503e-10f, 1.053879969e-10f, -5.686555046e-11f, -1.896286773e-11f, 6.802744999e-12f, 2.695195456e-11f, -1.158979943e-11f, -6.843983713e-12f, 1.279990003e-11f, 1.807650600e-12f, 5.954976963e-12f, -3.351478166e-12f, 6.802744674e-13f, -1.670379113e-12f, 1.751403167e-12f, -6.843983930e-13f, -5.389994549e-13f, 9.083608431e-13f};

struct Args { const float* in[21]; float* out; unsigned char* ws; int ph_lo, ph_hi, li, pad; };
enum { I_XP = 0, I_XS, I_CK, I_CV, I_SCONV, I_SDELTA, I_WIN, I_BATTN, I_SINKS, I_WCONV, I_ALOG, I_DTB, I_NORMW, I_WOUT, I_LN1G, I_LN1B, I_WGATE, I_WUP, I_WDOWN, I_LN2G, I_LN2B };

template <int MODE> DI int rowmap(int n) { return MODE == 0 ? n : (256 * (n >> 7) + (n & 127) + (MODE == 2 ? 128 : 0)); }
template <int MODE> DI void p0_tile(const float* __restrict__ W, int N, int K, bf16* __restrict__ WT, LAS unsigned short* scr, int kb, int nb, int lane) {
    const int k0 = 64 * kb, n0 = 64 * nb, n = n0 + lane; const bool ok = n < N;
    const float* src = W + (size_t)k0 * N + (ok ? n : 0);
#pragma unroll 16
    for (int kk = 0; kk < 64; ++kk) { const float v = src[(size_t)kk * N]; scr[kk * 66 + lane] = (unsigned short)f2bf(ok ? v : 0.f); }
    LDS_WAIT(); asm volatile("" ::: "memory");
    const int c = lane & 7, nn = lane >> 3;
#pragma unroll
    for (int p = 0; p < 8; ++p) { const int nl = nn + 8 * p, ng = n0 + nl;
        const LAS unsigned short* s = scr + (8 * c) * 66 + nl;
        v4u o; o.x = (unsigned)s[0] | ((unsigned)s[66] << 16); o.y = (unsigned)s[2 * 66] | ((unsigned)s[3 * 66] << 16); o.z = (unsigned)s[4 * 66] | ((unsigned)s[5 * 66] << 16); o.w = (unsigned)s[6 * 66] | ((unsigned)s[7 * 66] << 16);
        if (ng < N) *(v4u*)(WT + (size_t)rowmap<MODE>(ng) * K + k0 + 8 * c) = o; }
    LDS_WAIT(); asm volatile("" ::: "memory");
}
DI void p0_prologue(const Args& A, LAS unsigned char* lds, int gw, int NGW, int wave, int lane) {
    unsigned char* ws = A.ws;
    LAS unsigned short* scr = (LAS unsigned short*)(lds + RING_OFF + wave * 8448);
    constexpr int T_IN = 64 * 177, T_OUT = 64 * 64, T_G = 64 * 172, T_DN = 172 * 64, NT = T_IN + T_OUT + 2 * T_G + T_DN;
    for (int it = gw; it < NT; it += NGW) {
        int r = it;
        if (r < T_IN) { p0_tile<0>(A.in[I_WIN], INW, DM, (bf16*)(ws + WS_WIN), scr, r / 177, r % 177, lane); continue; } r -= T_IN;
        if (r < T_OUT) { p0_tile<0>(A.in[I_WOUT], DM, DM, (bf16*)(ws + WS_WOUT), scr, r / 64, r % 64, lane); continue; } r -= T_OUT;
        if (r < T_G) { p0_tile<1>(A.in[I_WGATE], FF, DM, (bf16*)(ws + WS_WGU), scr, r / 172, r % 172, lane); continue; } r -= T_G;
        if (r < T_G) { p0_tile<2>(A.in[I_WUP], FF, DM, (bf16*)(ws + WS_WGU), scr, r / 172, r % 172, lane); continue; } r -= T_G;
        p0_tile<0>(A.in[I_WDOWN], DM, FF, (bf16*)(ws + WS_WDN), scr, r / 64, r % 64, lane);
    }
    for (int m = gw; m < MPAD + (INP - INW); m += NGW) {
        if (m < MPAD) {
            v2u* o = (v2u*)((bf16*)(ws + WS_XB) + (size_t)m * DM) + lane;
            if (m < MROWS) { const f32x4* xr = (const f32x4*)(m < TP ? A.in[I_XP] + (size_t)m * DM : A.in[I_XS] + (size_t)(m - TP) * DM) + lane;
#pragma unroll 8
                for (int j = 0; j < 16; ++j) { const f32x4 v = xr[64 * j]; v2u w; w.x = cvtpk(v[0], v[1]); w.y = cvtpk(v[2], v[3]); o[64 * j] = w; } }
            else {
#pragma unroll 8
                for (int j = 0; j < 16; ++j) o[64 * j] = (v2u){0u, 0u}; }
        } else {
            v4u* o = (v4u*)((bf16*)(ws + WS_WIN) + (size_t)(INW + (m - MPAD)) * DM) + lane;
#pragma unroll
            for (int j = 0; j < 8; ++j) o[64 * j] = (v4u){0u, 0u, 0u, 0u};
        }
    }
    const int gt = gw * 64 + lane, NGT = NGW * 64;
    for (int i = gt; i < INP; i += NGT) ((float*)(ws + WS_BIASP))[i] = i < 3072 ? A.in[I_BATTN][i] : 0.f;
    for (int i = gt; i < 8193 * 32; i += NGT) { const int pos = i >> 5, f = i & 31; const float p = (float)pos, hi = ROPE_HI[f];
        const float r0 = p * hi, e0 = __builtin_fmaf(p, hi, -r0) + p * ROPE_LO[f]; float fr = r0 - __builtin_floorf(r0) + e0;
        f32x2 cs; cs.x = __builtin_amdgcn_cosf(fr); cs.y = __builtin_amdgcn_sinf(fr); ((f32x2*)(ws + WS_ROPE))[i] = cs; }
}

DI void p2_token(const Args& A, int row, int lane) {
    unsigned char* ws = A.ws; float* out = A.out;
    const bool smp = row >= TP; const int n = row - TP; const int pos = smp ? TP : row;
    const bf16* pr = (const bf16*)(ws + WS_PROJ) + (size_t)row * INP;
    const int part = lane & 3, hs = lane >> 2, d0 = 8 * part;
    f32x4 cs[4];
    { const f32x4* tp = (const f32x4*)((const float*)(ws + WS_ROPE) + ((size_t)pos * 32 + d0) * 2);
#pragma unroll
      for (int j = 0; j < 4; ++j) cs[j] = tp[j]; }
#pragma unroll
    for (int ps = 0; ps < 3; ++ps) { const int hh = 16 * ps + hs;
        if (hh < 40) {
            const v4u a = *(const v4u*)(pr + hh * 64 + d0), b = *(const v4u*)(pr + hh * 64 + 32 + d0);
            float x1[8], x2[8], o1[8], o2[8];
#pragma unroll
            for (int j = 0; j < 4; ++j) { x1[2 * j] = bflo(a[j]); x1[2 * j + 1] = bfhi(a[j]); x2[2 * j] = bflo(b[j]); x2[2 * j + 1] = bfhi(b[j]); }
#pragma unroll
            for (int j = 0; j < 8; ++j) { const float c = cs[j >> 1][(j & 1) * 2], s = cs[j >> 1][(j & 1) * 2 + 1]; o1[j] = x1[j] * c - x2[j] * s; o2[j] = x2[j] * c + x1[j] * s; }
            if (hh < 32) {
                if (!smp) { bf16* q = (bf16*)(ws + WS_QB) + (size_t)row * 2048 + hh * 64 + d0;
                    v4u w1, w2;
#pragma unroll
                    for (int j = 0; j < 4; ++j) { w1[j] = cvtpk(o1[2 * j] * QSCALE, o1[2 * j + 1] * QSCALE); w2[j] = cvtpk(o2[2 * j] * QSCALE, o2[2 * j + 1] * QSCALE); }
                    *(v4u*)q = w1; *(v4u*)(q + 32) = w2;
                } else { float* q = (float*)(ws + WS_SQA) + (size_t)n * 2048 + hh * 64 + d0;
#pragma unroll
                    for (int j = 0; j < 8; ++j) { q[j] = o1[j] * QSCALE; q[32 + j] = o2[j] * QSCALE; } }
            } else { const int kvh = hh - 32;
                if (!smp) { bf16* k = (bf16*)(ws + WS_KB) + (size_t)row * 512 + kvh * 64 + d0;
                    v4u w1, w2;
#pragma unroll
                    for (int j = 0; j < 4; ++j) { w1[j] = cvtpk(o1[2 * j], o1[2 * j + 1]); w2[j] = cvtpk(o2[2 * j], o2[2 * j + 1]); }
                    *(v4u*)k = w1; *(v4u*)(k + 32) = w2; }
                if (smp || row >= TP - 128) { float* k = smp ? out + O_SK + ((size_t)n * 128 + 127) * 512 + kvh * 64 + d0 : out + O_PK + (size_t)(row - (TP - 128)) * 512 + kvh * 64 + d0;
#pragma unroll
                    for (int j = 0; j < 8; ++j) { k[j] = o1[j]; k[32 + j] = o2[j]; } }
            }
        }
    }
    if (smp || row >= TP - 128) { float* v = smp ? out + O_SV + ((size_t)n * 128 + 127) * 512 : out + O_PV + (size_t)(row - (TP - 128)) * 512;
        const v4u a = *(const v4u*)(pr + OFF_V + 8 * lane);
#pragma unroll
        for (int j = 0; j < 4; ++j) { v[8 * lane + 2 * j] = bflo(a[j]); v[8 * lane + 2 * j + 1] = bfhi(a[j]); } }
    const float* wc = A.in[I_WCONV];
#pragma unroll 1
    for (int ps = 0; ps < 12; ++ps) { const int c0 = 512 * ps + 8 * lane;
        float xin[4][8];
#pragma unroll
        for (int j = 0; j < 4; ++j) {
            if (!smp) { const int r = row - 3 + j;
                if (r >= 0) { const v4u a = *(const v4u*)((const bf16*)(ws + WS_PROJ) + (size_t)r * INP + OFF_PRE + c0);
#pragma unroll
                    for (int e = 0; e < 4; ++e) { xin[j][2 * e] = bflo(a[e]); xin[j][2 * e + 1] = bfhi(a[e]); } }
                else {
#pragma unroll
                    for (int e = 0; e < 8; ++e) xin[j][e] = 0.f; }
            } else {
                if (j < 3) { const f32x4* sp = (const f32x4*)(A.in[I_SCONV] + ((size_t)n * 3 + j) * CONVD + c0); const f32x4 s0 = sp[0], s1 = sp[1];
#pragma unroll
                    for (int e = 0; e < 4; ++e) { xin[j][e] = s0[e]; xin[j][4 + e] = s1[e]; } }
                else { const v4u a = *(const v4u*)(pr + OFF_PRE + c0);
#pragma unroll
                    for (int e = 0; e < 4; ++e) { xin[j][2 * e] = bflo(a[e]); xin[j][2 * e + 1] = bfhi(a[e]); } }
            }
        }
        float y[8];
#pragma unroll
        for (int e = 0; e < 8; ++e) y[e] = 0.f;
#pragma unroll
        for (int j = 0; j < 4; ++j) { const f32x4* wp = (const f32x4*)(wc + (size_t)j * CONVD + c0); const f32x4 w0 = wp[0], w1 = wp[1];
#pragma unroll
            for (int e = 0; e < 4; ++e) { y[e] += w0[e] * xin[j][e]; y[4 + e] += w1[e] * xin[j][4 + e]; } }
        float ss = 0.f;
#pragma unroll
        for (int e = 0; e < 8; ++e) { y[e] = silu_acc(y[e]); ss += y[e] * y[e]; }
        if (ps < 8) {
            ss += __shfl_xor(ss, 1); ss += __shfl_xor(ss, 2); ss += __shfl_xor(ss, 4); ss += __shfl_xor(ss, 8);
            const float rn = (1.0f / sqrtf(ss + RMS_EPS)) * (ps < 4 ? 0.08838834764831845f : 1.0f);
#pragma unroll
            for (int e = 0; e < 8; ++e) y[e] *= rn;
        }
        const int cc = (ps & 3) * 512 + 8 * lane;
        if (!smp) { bf16* dst = (bf16*)(ws + (ps < 4 ? WS_QH : (ps < 8 ? WS_KH : WS_VH))) + (size_t)row * 2048 + cc;
            v4u w;
#pragma unroll
            for (int e = 0; e < 4; ++e) w[e] = cvtpk(y[2 * e], y[2 * e + 1]);
            *(v4u*)dst = w;
        } else { float* dst = (float*)(ws + (ps < 4 ? WS_SQD : (ps < 8 ? WS_SKD : WS_SVD))) + (size_t)n * 2048 + cc;
            *(f32x4*)dst = (f32x4){y[0], y[1], y[2], y[3]}; *(f32x4*)(dst + 4) = (f32x4){y[4], y[5], y[6], y[7]}; }
        if (!smp) { if (row >= TP - 3) { float* d = out + O_PC + (size_t)(row - (TP - 3)) * CONVD + c0;
                *(f32x4*)d = (f32x4){xin[3][0], xin[3][1], xin[3][2], xin[3][3]}; *(f32x4*)(d + 4) = (f32x4){xin[3][4], xin[3][5], xin[3][6], xin[3][7]}; } }
        else { float* d = out + O_SC + (size_t)n * 3 * CONVD + c0;
#pragma unroll
            for (int j = 0; j < 3; ++j) { *(f32x4*)(d + (size_t)j * CONVD) = (f32x4){xin[j + 1][0], xin[j + 1][1], xin[j + 1][2], xin[j + 1][3]}; *(f32x4*)(d + (size_t)j * CONVD + 4) = (f32x4){xin[j + 1][4], xin[j + 1][5], xin[j + 1][6], xin[j + 1][7]}; } }
    }
    if (lane < 16) { const float* ab = (const float*)(ws + WS_AB) + (size_t)row * 32; const float a = ab[lane] + A.in[I_DTB][lane], b = ab[16 + lane];
        const float sp = a > 20.f ? a : log1pf(expf(a)); const float g = -expf(A.in[I_ALOG][lane]) * sp; const float be = 1.0f / (1.0f + expf(-b));
        if (!smp) { float* gb = (float*)(ws + WS_GB) + (size_t)row * 32; gb[lane] = g; gb[16 + lane] = be; }
        else { float* gs = (float*)(ws + WS_SQA); (void)gs; float* gb2 = (float*)(ws + WS_GL) + 4096 + (size_t)n * 32; gb2[lane] = g; gb2[16 + lane] = be; } }
}

constexpr size_t WS_GBS = WS_GL + 16384;

DI void p3_item(const Args& A, int it, LAS unsigned char* lds, int tid, int wave, int lane) {
    unsigned char* ws = A.ws;
    const int hh = it >> 7, ck = it & 127, t0 = ck * 64;
    LAS unsigned short* KH = (LAS unsigned short*)(lds);
    LAS unsigned short* QH = (LAS unsigned short*)(lds + 17408);
    LAS float* AMT = (LAS float*)(lds + 34816);
    LAS float* CUM = (LAS float*)(lds + 52224);
    LAS float* BET = CUM + 64;
    const bf16* kh = (const bf16*)(ws + WS_KH); const bf16* qh = (const bf16*)(ws + WS_QH); const bf16* vh = (const bf16*)(ws + WS_VH);
#pragma unroll
    for (int p = 0; p < 2; ++p) { const int c = tid + 512 * p, r = c >> 4, ch = c & 15; const size_t go = (size_t)(t0 + r) * 2048 + hh * 128 + ch * 8;
        *(LAS v4u*)(KH + r * 136 + ch * 8) = *(const v4u*)(kh + go); *(LAS v4u*)(QH + r * 136 + ch * 8) = *(const v4u*)(qh + go); }
    if (tid < 64) { const float* gb = (const float*)(ws + WS_GB) + (size_t)(t0 + tid) * 32; float c = gb[hh];
#pragma unroll
        for (int o = 1; o < 64; o <<= 1) { const float t = __shfl_up(c, o); if (lane >= o) c += t; }
        CUM[tid] = c; BET[tid] = gb[16 + hh]; }
    __syncthreads();
    {
        const int which = wave >> 2, ti = (wave >> 1) & 1, tj = wave & 1, l31 = lane & 31, hl = lane >> 5;
        const LAS unsigned short* As = (which ? QH : KH) + (32 * ti + l31) * 136 + 8 * hl; const LAS unsigned short* Bs = KH + (32 * tj + l31) * 136 + 8 * hl;
        f32x16 x;
#pragma unroll
        for (int r = 0; r < 16; ++r) x[r] = 0.f;
#pragma unroll
        for (int s = 0; s < 8; ++s) { const bf16x8 a = *(const LAS bf16x8*)(As + 16 * s), b = *(const LAS bf16x8*)(Bs + 16 * s); x = MFMA32(a, b, x); }
        const int j = 32 * tj + l31; const float cj = CUM[j];
        bf16* att = (bf16*)(ws + WS_CAT) + (size_t)it * 4096;
#pragma unroll
        for (int r = 0; r < 16; ++r) { const int i = 32 * ti + crow32(r, hl); const float dec = __expf(fminf(CUM[i] - cj, 0.f));
            if (which == 0) { if (i > j) AMT[j * 68 + i] = BET[i] * x[r] * dec; }
            else { const float v = i >= j ? x[r] * dec : 0.f; att[i * 64 + j] = (bf16)f2bf(v); } }
    }
    __syncthreads();
    if (tid < 256) {
        float x[64];
        if (tid < 128) { const int c = tid; const float cl = CUM[63];
            bf16* kd = (bf16*)(ws + WS_CKD) + (size_t)it * 8192 + c * 64;
#pragma unroll
            for (int g = 0; g < 8; ++g) { float kv[8];
#pragma unroll
                for (int e = 0; e < 8; ++e) { const int t = 8 * g + e; const float k = bf2f(KH[t * 136 + c]); const float cu = CUM[t]; kv[e] = k * __expf(cl - cu); x[t] = k * BET[t] * __expf(cu); }
                v4u w; w.x = cvtpk(kv[0], kv[1]); w.y = cvtpk(kv[2], kv[3]); w.z = cvtpk(kv[4], kv[5]); w.w = cvtpk(kv[6], kv[7]); *(v4u*)(kd + 8 * g) = w; }
        } else { const int c = tid - 128; const bf16* vp = vh + (size_t)t0 * 2048 + hh * 128 + c;
#pragma unroll
            for (int t = 0; t < 64; ++t) x[t] = bf2f(vp[(size_t)t * 2048]) * BET[t];
        }
#pragma unroll
        for (int j = 0; j < 63; ++j) { const float xj = x[j];
#pragma unroll
            for (int a4 = (j + 1) / 4; a4 < 16; ++a4) { const f32x4 av = *(const LAS f32x4*)(AMT + j * 68 + 4 * a4);
#pragma unroll
                for (int e = 0; e < 4; ++e) { const int i = 4 * a4 + e; if (i > j) x[i] -= av[e] * xj; } } }
        if (tid < 128) { bf16* wn = (bf16*)(ws + WS_CWN) + (size_t)it * 8192 + tid;
#pragma unroll
            for (int t = 0; t < 64; ++t) wn[t * 128] = (bf16)f2bf(-x[t]);
        } else { float* u = (float*)(ws + WS_CU) + (size_t)it * 8192 + (tid - 128);
#pragma unroll
            for (int t = 0; t < 64; ++t) u[t * 128] = x[t];
        }
    } else {
        bf16* qd = (bf16*)(ws + WS_CQD) + (size_t)it * 8192;
#pragma unroll
        for (int p = 0; p < 4; ++p) { const int c = (tid - 256) + 256 * p, r = c >> 4, ch = c & 15; const float ga = __expf(CUM[r]);
            const v4u a = *(const LAS v4u*)(QH + r * 136 + ch * 8); v4u w;
#pragma unroll
            for (int e = 0; e < 4; ++e) w[e] = cvtpk(bflo(a[e]) * ga, bfhi(a[e]) * ga);
            *(v4u*)(qd + r * 128 + ch * 8) = w; }
        if (tid == 256) ((float*)(ws + WS_GL))[it] = __expf(CUM[63]);
    }
    __syncthreads();
}

DI bf16x8 ldfrag(const bf16* p) { return *(const bf16x8*)p; }
DI void p4_scan(const Args& A, int item, int lane) {
    unsigned char* ws = A.ws;
    const int hh = item >> 3, cs = item & 7, q = lane >> 4, cc = lane & 15;
    const int rslot = 8 * (cc >> 2) + (cc & 3);
    f32x4 S[8];
#pragma unroll
    for (int m = 0; m < 8; ++m) S[m] = (f32x4){0.f, 0.f, 0.f, 0.f};
    const bf16* Wn = (const bf16*)(ws + WS_CWN) + (size_t)hh * 128 * 8192; const bf16* Qd = (const bf16*)(ws + WS_CQD) + (size_t)hh * 128 * 8192;
    const bf16* Kd = (const bf16*)(ws + WS_CKD) + (size_t)hh * 128 * 8192; const bf16* At = (const bf16*)(ws + WS_CAT) + (size_t)hh * 128 * 4096;
    const float* U = (const float*)(ws + WS_CU) + (size_t)hh * 128 * 8192 + cs * 16 + cc; const float* GL = (const float*)(ws + WS_GL) + hh * 128;
    float* orw = (float*)(ws + WS_ORAW) + hh * 128 + cs * 16 + cc;
#pragma unroll 1
    for (int ck = 0; ck < NCHUNK; ++ck) {
        const bf16* w = Wn + (size_t)ck * 8192; const bf16* qd = Qd + (size_t)ck * 8192; const bf16* kd = Kd + (size_t)ck * 8192; const bf16* at = At + (size_t)ck * 4096; const float* u = U + (size_t)ck * 8192;
        bf16x8 Sb[4];
#pragma unroll
        for (int s = 0; s < 4; ++s) Sb[s] = pack8(S[2 * s], S[2 * s + 1]);
        f32x4 P[4];
#pragma unroll
        for (int mt = 0; mt < 4; ++mt) { const int tb = 32 * (mt >> 1) + 8 * q + 4 * (mt & 1);
#pragma unroll
            for (int r = 0; r < 4; ++r) P[mt][r] = u[(tb + r) * 128]; }
#pragma unroll
        for (int mt = 0; mt < 4; ++mt) { const int row = 32 * (mt >> 1) + 4 * (mt & 1) + rslot;
#pragma unroll
            for (int s = 0; s < 4; ++s) P[mt] = MFMA16(ldfrag(w + row * 128 + 32 * s + 8 * q), Sb[s], P[mt]); }
        bf16x8 Ub[2]; Ub[0] = pack8(P[0], P[1]); Ub[1] = pack8(P[2], P[3]);
        f32x4 O[4];
#pragma unroll
        for (int mt = 0; mt < 4; ++mt) { const int row = 32 * (mt >> 1) + 4 * (mt & 1) + rslot; O[mt] = (f32x4){0.f, 0.f, 0.f, 0.f};
#pragma unroll
            for (int s = 0; s < 4; ++s) O[mt] = MFMA16(ldfrag(qd + row * 128 + 32 * s + 8 * q), Sb[s], O[mt]);
#pragma unroll
            for (int s = 0; s < 2; ++s) if (s <= (mt >> 1)) O[mt] = MFMA16(ldfrag(at + row * 64 + 32 * s + 8 * q), Ub[s], O[mt]); }
#pragma unroll
        for (int mt = 0; mt < 4; ++mt) { const int tb = ck * 64 + 32 * (mt >> 1) + 8 * q + 4 * (mt & 1);
#pragma unroll
            for (int r = 0; r < 4; ++r) orw[(size_t)(tb + r) * 2048] = O[mt][r]; }
        const float gl = GL[ck];
#pragma unroll
        for (int m = 0; m < 8; ++m) { const int row = 32 * (m >> 1) + 4 * (m & 1) + rslot; S[m] = S[m] * gl;
#pragma unroll
            for (int s = 0; s < 2; ++s) S[m] = MFMA16(ldfrag(kd + row * 64 + 32 * s + 8 * q), Ub[s], S[m]); }
    }
    float* pd = A.out + O_PD + (size_t)hh * 128 * 128 + cs * 16 + cc;
#pragma unroll
    for (int m = 0; m < 8; ++m) { const int db = 32 * (m >> 1) + 8 * q + 4 * (m & 1);
#pragma unroll
        for (int r = 0; r < 4; ++r) pd[(db + r) * 128] = S[m][r]; }
}

DI void p4_attn(const Args& A, int item, int lane) {
    unsigned char* ws = A.ws;
    const int qt = item >> 5, h = item & 31, kvh = h >> 2, l31 = lane & 31, hl = lane >> 5;
    const int qpos = 32 * qt + l31;
    const bf16* Qb = (const bf16*)(ws + WS_QB) + (size_t)qpos * 2048 + h * 64 + 8 * hl;
    bf16x8 qf[4];
#pragma unroll
    for (int s = 0; s < 4; ++s) qf[s] = *(const bf16x8*)(Qb + 16 * s);
    const float sink2 = A.in[I_SINKS][h] * LOG2E;
    float mx = sink2;
    f32x16 sc[5];
#pragma unroll
    for (int kk = 0; kk < 5; ++kk) { const int kt = qt - 4 + kk;
        f32x16 x;
#pragma unroll
        for (int r = 0; r < 16; ++r) x[r] = 0.f;
        if (kt >= 0) { const bf16* Kb = (const bf16*)(ws + WS_KB) + (size_t)(32 * kt + l31) * 512 + kvh * 64 + 8 * hl;
#pragma unroll
            for (int s = 0; s < 4; ++s) x = MFMA32(*(const bf16x8*)(Kb + 16 * s), qf[s], x); }
#pragma unroll
        for (int r = 0; r < 16; ++r) { const int diff = qpos - (32 * kt + crow32(r, hl)); const bool ok = (kt >= 0) && diff >= 0 && diff < 128; x[r] = ok ? x[r] : -INFINITY; mx = fmaxf(mx, x[r]); }
        sc[kk] = x; }
    mx = fmaxf(mx, __shfl_xor(mx, 32));
    float l = 0.f;
#pragma unroll
    for (int kk = 0; kk < 5; ++kk)
#pragma unroll
        for (int r = 0; r < 16; ++r) { const float p = __builtin_amdgcn_exp2f(sc[kk][r] - mx); sc[kk][r] = p; l += p; }
    l += __shfl_xor(l, 32); l += __builtin_amdgcn_exp2f(sink2 - mx);
    f32x16 o0, o1;
#pragma unroll
    for (int r = 0; r < 16; ++r) { o0[r] = 0.f; o1[r] = 0.f; }
    const bf16* Vb = (const bf16*)(ws + WS_PROJ) + OFF_V + kvh * 64 + l31;
#pragma unroll
    for (int kk = 0; kk < 5; ++kk) { const int kt = qt - 4 + kk;
        if (kt >= 0) {
#pragma unroll
            for (int s = 0; s < 2; ++s) { v4u pw;
#pragma unroll
                for (int e = 0; e < 4; ++e) pw[e] = cvtpk(sc[kk][8 * s + 2 * e], sc[kk][8 * s + 2 * e + 1]);
                const bf16x8 pb = __builtin_bit_cast(bf16x8, pw);
                v4u v0, v1;
#pragma unroll
                for (int e = 0; e < 4; ++e) { const int k0 = 32 * kt + 16 * s + 8 * ((2 * e) >> 2) + 4 * hl + ((2 * e) & 3), k1 = k0 + 1;
                    const bf16* r0 = Vb + (size_t)k0 * INP; const bf16* r1 = Vb + (size_t)k1 * INP;
                    v0[e] = (unsigned)r0[0] | ((unsigned)r1[0] << 16); v1[e] = (unsigned)r0[32] | ((unsigned)r1[32] << 16); }
                o0 = MFMA32(__builtin_bit_cast(bf16x8, v0), pb, o0); o1 = MFMA32(__builtin_bit_cast(bf16x8, v1), pb, o1); } } }
    const float inv = 1.0f / l;
    bf16* mix = (bf16*)(ws + WS_XB) + (size_t)qpos * DM + h * 64 + 4 * hl;
#pragma unroll
    for (int g = 0; g < 4; ++g) { v2u w0, w1; w0.x = cvtpk(o0[4 * g] * inv, o0[4 * g + 1] * inv); w0.y = cvtpk(o0[4 * g + 2] * inv, o0[4 * g + 3] * inv);
        w1.x = cvtpk(o1[4 * g] * inv, o1[4 * g + 1] * inv); w1.y = cvtpk(o1[4 * g + 2] * inv, o1[4 * g + 3] * inv);
        *(v2u*)(mix + 8 * g) = w0; *(v2u*)(mix + 32 + 8 * g) = w1; }
}

DI float rdlane(float v, int l) { return __int_as_float(__builtin_amdgcn_readlane(__float_as_int(v), l)); }
DI void p4_sattn(const Args& A, int item, int lane) {
    unsigned char* ws = A.ws;
    const int n = item >> 3, kvh = item & 7;
    const float* ck = A.in[I_CK] + (size_t)n * 128 * 512 + kvh * 64; const float* cv = A.in[I_CV] + (size_t)n * 128 * 512 + kvh * 64;
    float* ok = A.out + O_SK + (size_t)n * 128 * 512 + kvh * 64; float* ov = A.out + O_SV + (size_t)n * 128 * 512 + kvh * 64;
    const float* qs = (const float*)(ws + WS_SQA) + (size_t)n * 2048 + kvh * 256 + lane;
    float qv[4];
#pragma unroll
    for (int hq = 0; hq < 4; ++hq) qv[hq] = qs[hq * 64];
    float sc[4][2];
#pragma unroll
    for (int half = 0; half < 2; ++half) { const int idx = lane + 64 * half;
        const f32x4* src = (const f32x4*)(idx < 127 ? ck + (size_t)(idx + 1) * 512 : ok + (size_t)127 * 512);
        f32x4 kr[16];
#pragma unroll
        for (int c = 0; c < 16; ++c) kr[c] = src[c];
        if (idx < 127) { f32x4* dst = (f32x4*)(ok + (size_t)idx * 512);
#pragma unroll
            for (int c = 0; c < 16; ++c) dst[c] = kr[c]; }
        float s0 = 0.f, s1 = 0.f, s2 = 0.f, s3 = 0.f;
#pragma unroll
        for (int d = 0; d < 64; ++d) { const float kd = kr[d >> 2][d & 3]; s0 += kd * rdlane(qv[0], d); s1 += kd * rdlane(qv[1], d); s2 += kd * rdlane(qv[2], d); s3 += kd * rdlane(qv[3], d); }
        sc[0][half] = s0; sc[1][half] = s1; sc[2][half] = s2; sc[3][half] = s3; }
#pragma unroll
    for (int hq = 0; hq < 4; ++hq) { const float sink2 = A.in[I_SINKS][4 * kvh + hq] * LOG2E;
        const float m = fmaxf(wave_max(fmaxf(sc[hq][0], sc[hq][1])), sink2);
        const float p0 = __builtin_amdgcn_exp2f(sc[hq][0] - m), p1 = __builtin_amdgcn_exp2f(sc[hq][1] - m);
        const float l = wave_sum(p0 + p1) + __builtin_amdgcn_exp2f(sink2 - m); const float inv = 1.0f / l;
        sc[hq][0] = p0 * inv; sc[hq][1] = p1 * inv; }
    float o[4] = {0.f, 0.f, 0.f, 0.f};
#pragma unroll
    for (int half = 0; half < 2; ++half)
#pragma unroll
        for (int jj = 0; jj < 64; ++jj) { const int j = 64 * half + jj;
            const float v = j < 127 ? cv[(size_t)(j + 1) * 512 + lane] : ov[(size_t)127 * 512 + lane];
            if (j < 127) ov[(size_t)j * 512 + lane] = v;
#pragma unroll
            for (int hq = 0; hq < 4; ++hq) o[hq] += rdlane(sc[hq][half], jj) * v; }
    bf16* mix = (bf16*)(ws + WS_XB) + (size_t)(TP + n) * DM + kvh * 256 + lane;
#pragma unroll
    for (int hq = 0; hq < 4; ++hq) mix[hq * 64] = (bf16)f2bf(o[hq]);
}

DI void p4_sdn_pair(const Args& A, int pairIdx, LAS unsigned char* lds, int tid, int lane) {
    unsigned char* ws = A.ws;
    const int half = tid >> 8, t = tid & 255, w4 = t >> 6;
    const int item = 2 * pairIdx + half, n = item >> 4, hh = item & 15;
    LAS float* KV = (LAS float*)(lds + half * 8192);
    LAS float* RED = KV + 384; LAS float* RED2 = KV + 896;
    if (t < 128) { const size_t go = (size_t)n * 2048 + hh * 128 + t;
        KV[t] = ((const float*)(ws + WS_SKD))[go]; KV[128 + t] = ((const float*)(ws + WS_SQD))[go]; KV[256 + t] = ((const float*)(ws + WS_SVD))[go]; }
    const float* gbs = (const float*)(ws + WS_GBS) + (size_t)n * 32; const float eg = __expf(gbs[hh]), be = gbs[16 + hh];
    const size_t so = ((size_t)(n * 16 + hh) * 128 + 32 * w4) * 128 + 2 * lane;
    const float* Sg = A.in[I_SDELTA] + so; float* So = A.out + O_SD + so;
    f32x2 s[32];
#pragma unroll
    for (int i = 0; i < 32; ++i) s[i] = *(const f32x2*)(Sg + i * 128);
    __syncthreads();
    f32x2 r = {0.f, 0.f};
#pragma unroll
    for (int i = 0; i < 32; ++i) r += s[i] * KV[32 * w4 + i];
    *(LAS f32x2*)(RED + w4 * 128 + 2 * lane) = r;
    __syncthreads();
    const f32x2 rt = *(const LAS f32x2*)(RED + 2 * lane) + *(const LAS f32x2*)(RED + 128 + 2 * lane) + *(const LAS f32x2*)(RED + 256 + 2 * lane) + *(const LAS f32x2*)(RED + 384 + 2 * lane);
    const f32x2 u = (*(const LAS f32x2*)(KV + 256 + 2 * lane) - rt * eg) * be;
    f32x2 o = {0.f, 0.f};
#pragma unroll
    for (int i = 0; i < 32; ++i) { const float kk = KV[32 * w4 + i], qq = KV[128 + 32 * w4 + i]; const f32x2 sn = s[i] * eg + u * kk; *(f32x2*)(So + i * 128) = sn; o += sn * qq; }
    *(LAS f32x2*)(RED2 + w4 * 128 + 2 * lane) = o;
    __syncthreads();
    if (w4 == 0) {
        const f32x2 ot = *(const LAS f32x2*)(RED2 + 2 * lane) + *(const LAS f32x2*)(RED2 + 128 + 2 * lane) + *(const LAS f32x2*)(RED2 + 256 + 2 * lane) + *(const LAS f32x2*)(RED2 + 384 + 2 * lane);
        const float ss = wave_sum(ot.x * ot.x + ot.y * ot.y); const float rn = 1.0f / sqrtf(ss * (1.0f / 128.0f) + RMS_EPS);
        const unsigned zz = *(const unsigned*)((const bf16*)(ws + WS_PROJ) + (size_t)(TP + n) * INP + OFF_Z + hh * 128 + 2 * lane);
        const f32x2 nw = *(const f32x2*)(A.in[I_NORMW] + 2 * lane);
        const float y0 = ot.x * rn * nw.x * silu_acc(bflo(zz)), y1 = ot.y * rn * nw.y * silu_acc(bfhi(zz));
        *(unsigned*)((bf16*)(ws + WS_XB) + (size_t)(TP + n) * DM + 2048 + hh * 128 + 2 * lane) = cvtpk(y0, y1);
    }
    __syncthreads();
}

DI void p5_token(const Args& A, int t, int lane) {
    unsigned char* ws = A.ws;
    const float* o = (const float*)(ws + WS_ORAW) + (size_t)t * 2048; const bf16* z = (const bf16*)(ws + WS_PROJ) + (size_t)t * INP + OFF_Z; bf16* mix = (bf16*)(ws + WS_XB) + (size_t)t * DM + 2048;
    const f32x4 n0 = *(const f32x4*)(A.in[I_NORMW] + 8 * (lane & 15)), n1 = *(const f32x4*)(A.in[I_NORMW] + 8 * (lane & 15) + 4);
#pragma unroll
    for (int ps = 0; ps < 4; ++ps) { const int c0 = 512 * ps + 8 * lane;
        const f32x4 a = *(const f32x4*)(o + c0), b = *(const f32x4*)(o + c0 + 4); const v4u zz = *(const v4u*)(z + c0);
        float ss = (a[0] * a[0] + a[1] * a[1]) + (a[2] * a[2] + a[3] * a[3]) + (b[0] * b[0] + b[1] * b[1]) + (b[2] * b[2] + b[3] * b[3]);
        ss += __shfl_xor(ss, 1); ss += __shfl_xor(ss, 2); ss += __shfl_xor(ss, 4); ss += __shfl_xor(ss, 8);
        const float rn = 1.0f / sqrtf(ss * (1.0f / 128.0f) + RMS_EPS);
        v4u w;
        w.x = cvtpk(a[0] * rn * n0[0] * silu_acc(bflo(zz[0])), a[1] * rn * n0[1] * silu_acc(bfhi(zz[0])));
        w.y = cvtpk(a[2] * rn * n0[2] * silu_acc(bflo(zz[1])), a[3] * rn * n0[3] * silu_acc(bfhi(zz[1])));
        w.z = cvtpk(b[0] * rn * n1[0] * silu_acc(bflo(zz[2])), b[1] * rn * n1[1] * silu_acc(bfhi(zz[2])));
        w.w = cvtpk(b[2] * rn * n1[2] * silu_acc(bflo(zz[3])), b[3] * rn * n1[3] * silu_acc(bfhi(zz[3])));
        *(v4u*)(mix + c0) = w; }
}

DI void ln_row(const float* src, const float* g, const float* b, float* dstf, bf16* dstb, int lane) {
    const f32x4* xr = (const f32x4*)src + lane;
    f32x4 v[16]; float s = 0.f;
#pragma unroll
    for (int j = 0; j < 16; ++j) { v[j] = xr[64 * j]; s += (v[j][0] + v[j][1]) + (v[j][2] + v[j][3]); }
    const float mean = wave_sum(s) * (1.0f / DM); float s2 = 0.f;
#pragma unroll
    for (int j = 0; j < 16; ++j) { v[j] = v[j] - mean; s2 += (v[j][0] * v[j][0] + v[j][1] * v[j][1]) + (v[j][2] * v[j][2] + v[j][3] * v[j][3]); }
    const float rstd = 1.0f / sqrtf(wave_sum(s2) * (1.0f / DM) + LN_EPS);
    const f32x4* g4 = (const f32x4*)g + lane; const f32x4* b4 = (const f32x4*)b + lane;
#pragma unroll
    for (int j = 0; j < 16; ++j) { const f32x4 y = v[j] * rstd * g4[64 * j] + b4[64 * j];
        if (dstf) ((f32x4*)dstf + lane)[64 * j] = y;
        if (dstb) { v2u w; w.x = cvtpk(y[0], y[1]); w.y = cvtpk(y[2], y[3]); ((v2u*)dstb + lane)[64 * j] = w; } }
}

#ifndef MK_N_LAUNCHES
#define MK_N_LAUNCHES 1
#endif
constexpr int N_PHASES = 11;
constexpr int N_LAUNCHES = MK_N_LAUNCHES;
constexpr int NSCAN = 128;

__global__ void __launch_bounds__(NTHR, 2) fwd(Args args) {
    extern __shared__ __attribute__((aligned(16))) unsigned char lds_raw[];
    LAS unsigned char* lds = (LAS unsigned char*)lds_raw;
    volatile LAS unsigned* MISC = (volatile LAS unsigned*)(lds + MISC_OFF);
    const int tid = threadIdx.x, lane = tid & 63, wave = __builtin_amdgcn_readfirstlane(tid >> 6);
    const int G = gridDim.x, bx = blockIdx.x, gw = bx * NWAVES + wave, NGW = G * NWAVES;
    unsigned char* ws = args.ws;
    gu32* ctl = (gu32*)(ws + WS_CTL);
    for (int u = tid; u < (LDS_BYTES - LDSCTL_OFF) / 4; u += NTHR) ((LAS unsigned*)(lds + LDSCTL_OFF))[u] = 0u;
    __syncthreads();
    XcdBarrier bar; bar.bar = (unsigned*)(ctl + CW_BAR); bar.x = 0; bar.st = nullptr;
    if (N_LAUNCHES == 1) bar = xcd_barrier_post((unsigned*)(ctl + CW_BAR), MISC + 8);
#define GRID_BAR() do { if (N_LAUNCHES == 1) xcd_barrier(bar); } while (0)
    const int lo = args.ph_lo, hi = args.ph_hi;
#define IN(k) (lo <= (k) && (k) < hi)
#define BOTH(k) (IN(k) && IN((k) + 1))

    if (IN(0)) { p0_prologue(args, lds, gw, NGW, wave, lane); if (BOTH(0)) GRID_BAR(); }

    if (IN(1)) {
        pg8::Gemm g{(const pg8::bf16_t*)(ws + WS_XB), (const pg8::bf16_t*)(ws + WS_WIN), MPAD, INP, DM}; pg8::StaticOrder S; S.init(MPAD, INP, G, bx);
        pg8::EpiProj E{(pg8::bf16_t*)(ws + WS_PROJ), INP, (const float*)(ws + WS_BIASP), (float*)(ws + WS_AB), OFF_AB / 256};
        pg8::gemm_phase<pg8::EpiProj, pg8::StaticOrder, true, true>(lds + RING_OFF, g, S, E);
        if (BOTH(1)) GRID_BAR();
    }

    if (IN(2)) {
        for (int row = gw; row < MROWS; row += NGW) p2_token(args, row, lane);
        if (BOTH(2)) GRID_BAR();
    }

    if (IN(3)) {
        for (int it = bx; it < NITEM; it += G) p3_item(args, it, lds, tid, wave, lane);
        if (BOTH(3)) GRID_BAR();
    }

    if (IN(4)) {
        if (bx < NSCAN) {
            if (wave == 0) { __builtin_amdgcn_s_setprio(3); p4_scan(args, bx, lane); __builtin_amdgcn_s_setprio(0); }
        } else {
            const int ob = bx - NSCAN, NOB = G - NSCAN;
            for (int p = ob; p < 1024; p += NOB) p4_sdn_pair(args, p, lds, tid, lane);
            for (int it = ob * NWAVES + wave; it < 1024; it += NOB * NWAVES) p4_sattn(args, it, lane);
        }
        if (!(bx < NSCAN && wave == 0)) {
            for (;;) { int it = 0; if (lane == 0) it = (int)__hip_atomic_fetch_add(ctl + CW_QATT, 1u, RLX_AGENT); it = __builtin_amdgcn_readfirstlane(it);
                if (it >= 256 * 32) break; p4_attn(args, it, lane); }
        }
        if (BOTH(4)) GRID_BAR();
    }

    if (IN(5)) {
        for (int t = gw; t < TP; t += NGW) p5_token(args, t, lane);
        if (BOTH(5)) GRID_BAR();
    }

    if (IN(6)) {
        pg8::Gemm g{(const pg8::bf16_t*)(ws + WS_XB), (const pg8::bf16_t*)(ws + WS_WOUT), MPAD, DM, DM}; pg8::StaticOrder S; S.init(MPAD, DM, G, bx);
        float* t1 = (float*)(ws + WS_PROJ);
        pg8::EpiRes E{args.in[I_XP], args.in[I_XS], t1, t1 + (size_t)TP * DM, TP, MROWS, DM, ALPHA};
        pg8::gemm_phase<pg8::EpiRes, pg8::StaticOrder, true, true>(lds + RING_OFF, g, S, E);
        if (BOTH(6)) GRID_BAR();
    }

    if (IN(7)) {
        float* t1 = (float*)(ws + WS_PROJ);
        for (int r = gw; r < MROWS; r += NGW) ln_row(t1 + (size_t)r * DM, args.in[I_LN1G], args.in[I_LN1B], t1 + (size_t)r * DM, (bf16*)(ws + WS_XB) + (size_t)r * DM, lane);
        if (BOTH(7)) GRID_BAR();
    }

    if (IN(8)) {
        pg8::Gemm g{(const pg8::bf16_t*)(ws + WS_XB), (const pg8::bf16_t*)(ws + WS_WGU), MPAD, NGU, DM}; pg8::StaticOrder S; S.init(MPAD, NGU, G, bx);
        pg8::EpiSwiGLU E{(pg8::bf16_t*)(ws + WS_FFN), FF};
        pg8::gemm_phase<pg8::EpiSwiGLU, pg8::StaticOrder, true, true>(lds + RING_OFF, g, S, E);
        if (BOTH(8)) GRID_BAR();
    }

    if (IN(9)) {
        pg8::Gemm g{(const pg8::bf16_t*)(ws + WS_FFN), (const pg8::bf16_t*)(ws + WS_WDN), MPAD, DM, FF}; pg8::StaticOrder S; S.init(MPAD, DM, G, bx);
        const float* h = (const float*)(ws + WS_PROJ);
        pg8::EpiRes E{h, h + (size_t)TP * DM, args.out + O_Y, args.out + O_Y + (size_t)TP * DM, TP, MROWS, DM, ALPHA};
        pg8::gemm_phase<pg8::EpiRes, pg8::StaticOrder, true, true>(lds + RING_OFF, g, S, E);
        if (BOTH(9)) GRID_BAR();
    }

    if (IN(10)) {
        float* y = args.out + O_Y;
        for (int r = gw; r < MROWS; r += NGW) ln_row(y + (size_t)r * DM, args.in[I_LN2G], args.in[I_LN2B], y + (size_t)r * DM, nullptr, lane);
    }
#undef IN
#undef BOTH
#undef GRID_BAR
}

extern "C" void kernel_launch(void* const* d_in, const int* in_sizes, int n_in, void* d_out, int out_size, void* d_ws, size_t ws_size, hipStream_t stream) {
    static int grid = 0;
    if (grid == 0) {
        if (n_in != 21 || (size_t)out_size != O_END || ws_size < WS_END) { fprintf(stderr, "kernel_launch: unexpected problem (n_in %d, out %d, ws %zu); nothing launched\n", n_in, out_size, ws_size); grid = -1; return; }
        int dev = 0, cus = 0, per_cu = 0;
        if (hipGetDevice(&dev) != hipSuccess || hipDeviceGetAttribute(&cus, hipDeviceAttributeMultiprocessorCount, dev) != hipSuccess) { grid = -1; return; }
        if (hipFuncSetAttribute((const void*)fwd, hipFuncAttributeMaxDynamicSharedMemorySize, LDS_BYTES) != hipSuccess) { fprintf(stderr, "kernel_launch: hipFuncSetAttribute failed\n"); grid = -1; return; }
        if (hipOccupancyMaxActiveBlocksPerMultiprocessor(&per_cu, (const void*)fwd, NTHR, LDS_BYTES) != hipSuccess || per_cu < 1) { fprintf(stderr, "kernel_launch: occupancy query reports %d workgroups per CU\n", per_cu); }
        (void)hipGetLastError();
        grid = cus;
        if (grid < 2 * NSCAN) { fprintf(stderr, "kernel_launch: needs >= %d CUs, device has %d\n", 2 * NSCAN, cus); grid = -1; return; }
    }
    if (grid < 0) return;
    if (hipMemsetAsync((char*)d_ws + WS_CTL, 0, CTL_ZERO_BYTES, stream) != hipSuccess) return;
    Args a{};
    for (int i = 0; i < 21; ++i) a.in[i] = (const float*)d_in[i];
    a.out = (float*)d_out; a.ws = (unsigned char*)d_ws;
    for (int li = 0; li < N_LAUNCHES; ++li) {
        a.ph_lo = (N_LAUNCHES == 1) ? 0 : li; a.ph_hi = (N_LAUNCHES == 1) ? N_PHASES : li + 1; a.li = li; a.pad = 0;
        hipLaunchKernelGGL(fwd, dim3(grid), dim3(NTHR), LDS_BYTES, stream, a);
        const hipError_t le = hipPeekAtLastError();
        if (le != hipSuccess) { fprintf(stderr, "kernel_launch: launch %d failed: %s\n", li, hipGetErrorName(le)); break; }
    }
}
```

```cpp
#include <hip/hip_runtime.h>
#include <cstdio>
#include <cstdint>
#include <cmath>
namespace pg8 {
#define PG8_LAS __attribute__((address_space(3)))
typedef unsigned short bf16_t;
typedef short bf16x8 __attribute__((ext_vector_type(8)));
typedef float f32x4 __attribute__((ext_vector_type(4)));
typedef unsigned u32x4 __attribute__((ext_vector_type(4)));
constexpr int BM = 256, BK = 64, HALF = 128, HTB = HALF * BK * 2  , STAGE_BYTES = 8 * HTB, NXCD = 8, WGM = 8;

__host__ __device__ __forceinline__ int lds_byte(int r, int c) { const int st = (r >> 4) * 2 + (c >> 5), rr = r & 15, cc = c & 31, ob = rr * 64 + cc * 2; return st * 1024 + (ob ^ (((ob >> 9) & 1) << 5)); }
__host__ __device__ __forceinline__ void stage_rc(int b, int& R, int& C) { const int st = b / 1024, sb = b % 1024, swz = sb ^ (((sb >> 9) & 1) << 5); R = (st >> 1) * 16 + swz / 64; C = (st & 1) * 32 + (swz % 64) / 2; }
__host__ __device__ __forceinline__ int perm32(int rho) { const int n = rho >> 4, i = rho & 15; return 8 * (i >> 2) + 4 * n + (i & 3); }

struct Unit { int pm, pn, k0, nt, ks; };
struct Gemm { const bf16_t* A; const bf16_t* Bt; int M, N, K; };

struct StaticOrder {
    int nM, nN, nwg, G, c, ntf;
    __host__ __device__ void init(int M, int N, int K, int G_, int c_) { nM = M / BM; nN = N / BM; nwg = nM * nN; G = G_; c = c_; ntf = K / BK; }
    __host__ __device__ __forceinline__ bool next(int i, Unit& u) const {
        const long L = (long)i * G + c; if (L >= nwg) return false;
        int wgid = (int)L; { const int q = nwg / NXCD, r = nwg % NXCD, xcd = wgid % NXCD, off = wgid / NXCD; wgid = (xcd < r ? xcd * (q + 1) : r * (q + 1) + (xcd - r) * q) + off; }
        const int nig = WGM * nN, gid = wgid / nig, fm = gid * WGM, gsz = (nM - fm) < WGM ? (nM - fm) : WGM;
        u.pm = fm + ((wgid % nig) % gsz); u.pn = (wgid % nig) / gsz; u.k0 = 0; u.nt = ntf; u.ks = 0; return true;
    }
    __device__ __forceinline__ void a_ready(const Unit&) const {}
    __device__ __forceinline__ void done(const Unit&) const {}
};

struct SplitTailOrder {
    int nMf, nN, nwg, G, c, ntf, S, base, rem;
    __host__ __device__ __forceinline__ void init(int Mfull, int N, int K, int S_, int G_, int c_) { nMf = Mfull / BM; nN = N / BM; nwg = nMf * nN; G = G_; c = c_; ntf = K / BK; S = S_; base = (K / (2 * BK)) / (S_ > 0 ? S_ : 1); rem = (K / (2 * BK)) % (S_ > 0 ? S_ : 1); }
    __host__ __device__ __forceinline__ bool next(int i, Unit& u) const {
        const int L = i * G + c; if (L >= nwg + nN * S) return false;
        const bool fu = L < nwg;
#if defined(PROBE_MASK)
        if (!fu && S < 0) return false;
#endif
        int wgid = fu ? L : 0; { const int q = nwg / NXCD, r = nwg % NXCD, xcd = wgid % NXCD, off = wgid / NXCD; wgid = (xcd < r ? xcd * (q + 1) : r * (q + 1) + (xcd - r) * q) + off; }
        const int nig = WGM * nN, gid = wgid / nig, fm = gid * WGM, gsz = (nMf - fm) < WGM ? (nMf - fm) : WGM;
        const int j = fu ? 0 : L - nwg, ks = j % S;
        u.pm = fu ? fm + ((wgid % nig) % gsz) : nMf; u.pn = fu ? (wgid % nig) / gsz : j / S; u.ks = ks;
        u.nt = fu ? ntf : 2 * (base + (ks < rem ? 1 : 0)); u.k0 = fu ? 0 : 2 * BK * (ks * base + (ks < rem ? ks : rem)); return true;
    }
    __device__ __forceinline__ void a_ready(const Unit&) const {}
    __device__ __forceinline__ void done(const Unit&) const {}
};

__device__ __forceinline__ unsigned cvt_pk_bf16(float lo, float hi) { unsigned r; asm volatile("v_cvt_pk_bf16_f32 %0, %1, %2" : "=v"(r) : "v"(lo), "v"(hi)); return r; }
typedef float f32x2 __attribute__((ext_vector_type(2)));

struct EpiProj {
    static constexpr bool PERM = true, AFTER_DRAIN = false;
    bf16_t* O; int ldc; const float* bias; float* ab; int ab_pn;
    __device__ __forceinline__ void operator()(const f32x4 (&acc)[2][2][4][2], const Unit& u, int wr, int wc, int fr, int fq) const {
        const int row0 = u.pm * BM + wr * 64 + fr; const int col0 = u.pn * BM + wc * 32 + 8 * fq;
        f32x4 bv[2][2];
#pragma unroll
        for (int bj = 0; bj < 2; ++bj)
#pragma unroll
            for (int n = 0; n < 2; ++n) bv[bj][n] = *(const f32x4*)(bias + col0 + bj * HALF + 4 * n);
        const bool do_ab = (u.pn == ab_pn) && (wc == 0);
#pragma unroll
        for (int ai = 0; ai < 2; ++ai)
#pragma unroll
            for (int m = 0; m < 4; ++m) { const int row = row0 + ai * HALF + m * 16; bf16_t* rowp = O + (size_t)row * ldc + col0;
#pragma unroll
                for (int bj = 0; bj < 2; ++bj) { const f32x4 v0 = acc[ai][bj][m][0] + bv[bj][0], v1 = acc[ai][bj][m][1] + bv[bj][1];
                    u32x4 w; w.x = cvt_pk_bf16(v0[0], v0[1]); w.y = cvt_pk_bf16(v0[2], v0[3]); w.z = cvt_pk_bf16(v1[0], v1[1]); w.w = cvt_pk_bf16(v1[2], v1[3]);
                    *(u32x4*)(rowp + bj * HALF) = w;
                    if (bj == 0 && do_ab) { float* ap = ab + (size_t)row * 32 + 8 * fq; *(f32x4*)ap = v0; *(f32x4*)(ap + 4) = v1; } } }
    }
};
struct EpiRes {
    static constexpr bool PERM = false, AFTER_DRAIN = false;
    const float* res0; const float* res1; float* out0; float* slab; int split, mrows, ldc, pm_s; float alpha; const bf16_t* resb; bf16_t* outb;
    static __device__ __forceinline__ f32x4 ldb4(const bf16_t* p) { const unsigned long long w = *(const unsigned long long*)p; const unsigned lo = (unsigned)w, hi = (unsigned)(w >> 32);
        return (f32x4){__uint_as_float(lo << 16), __uint_as_float(lo & 0xffff0000u), __uint_as_float(hi << 16), __uint_as_float(hi & 0xffff0000u)}; }
    __device__ __forceinline__ void operator()(const f32x4 (&acc)[2][2][4][2], const Unit& u, int wr, int wc, int fr, int fq) const {
        const int col0 = u.pn * BM + wc * 32 + 4 * fq;
        if (u.pm < pm_s) {
#pragma unroll
            for (int ai = 0; ai < 2; ++ai) {
                f32x4 rv[4][2][2];
#pragma unroll
                for (int m = 0; m < 4; ++m) { const size_t ro = (size_t)(u.pm * BM + ai * HALF + wr * 64 + m * 16 + fr) * ldc + col0;
#pragma unroll
                    for (int bj = 0; bj < 2; ++bj)
#pragma unroll
                        for (int n = 0; n < 2; ++n) rv[m][bj][n] = resb ? ldb4(resb + ro + bj * HALF + n * 16) : *(const f32x4*)(res0 + ro + bj * HALF + n * 16); }
                __builtin_amdgcn_sched_barrier(0);
#pragma unroll
                for (int m = 0; m < 4; ++m) { float* op = out0 + (size_t)(u.pm * BM + ai * HALF + wr * 64 + m * 16 + fr) * ldc + col0;
#pragma unroll
                    for (int bj = 0; bj < 2; ++bj)
#pragma unroll
                        for (int n = 0; n < 2; ++n) { const f32x4 o = rv[m][bj][n] * alpha + acc[ai][bj][m][n];
                            if (outb) { typedef unsigned u32x2 __attribute__((ext_vector_type(2))); u32x2 w; w.x = cvt_pk_bf16(o[0], o[1]); w.y = cvt_pk_bf16(o[2], o[3]); *(u32x2*)(outb + (size_t)(u.pm * BM + ai * HALF + wr * 64 + m * 16 + fr) * ldc + col0 + bj * HALF + n * 16) = w; }
                            else *(f32x4*)(op + bj * HALF + n * 16) = o; } }
            }
        } else {
#pragma unroll
            for (int m = 0; m < 4; ++m) { const int lr = wr * 64 + m * 16 + fr;
                if (lr < mrows - split) { const float* rp = res1 + (size_t)lr * ldc; float* op = slab + ((size_t)u.ks * HALF + lr) * ldc;
#pragma unroll
                    for (int bj = 0; bj < 2; ++bj)
#pragma unroll
                        for (int n = 0; n < 2; ++n) { const int c = col0 + bj * HALF + n * 16; f32x4 o = acc[0][bj][m][n]; if (u.ks == 0) o += (resb ? ldb4(resb + (size_t)(split + lr) * ldc + c) : *(const f32x4*)(rp + c)) * alpha; *(f32x4*)(op + c) = o; } } }
        }
    }
};
struct EpiSwiGLU {
    static constexpr bool PERM = true, AFTER_DRAIN = false;
    bf16_t* O; int ldc;
    static __device__ __forceinline__ float silu_mul(float g, float uu) { return g * uu * __builtin_amdgcn_rcpf(1.0f + __builtin_amdgcn_exp2f(-1.4426950408889634f * g)); }
    __device__ __forceinline__ void operator()(const f32x4 (&acc)[2][2][4][2], const Unit& u, int wr, int wc, int fr, int fq) const {
        const int row0 = u.pm * BM + wr * 64 + fr; const int col0 = u.pn * HALF + wc * 32 + 8 * fq;
#pragma unroll
        for (int ai = 0; ai < 2; ++ai)
#pragma unroll
            for (int m = 0; m < 4; ++m) { bf16_t* rowp = O + (size_t)(row0 + ai * HALF + m * 16) * ldc + col0;
                const f32x4 g0 = acc[ai][0][m][0], g1 = acc[ai][0][m][1], u0 = acc[ai][1][m][0], u1 = acc[ai][1][m][1];
                u32x4 w; w.x = cvt_pk_bf16(silu_mul(g0[0], u0[0]), silu_mul(g0[1], u0[1])); w.y = cvt_pk_bf16(silu_mul(g0[2], u0[2]), silu_mul(g0[3], u0[3]));
                w.z = cvt_pk_bf16(silu_mul(g1[0], u1[0]), silu_mul(g1[1], u1[1])); w.w = cvt_pk_bf16(silu_mul(g1[2], u1[2]), silu_mul(g1[3], u1[3]));
                *(u32x4*)rowp = w; }
    }
};
template <class Epi, class Sched, bool ALIGN_EPI = false, bool SP2 = false>
__device__ __forceinline__ void gemm_phase(PG8_LAS unsigned char* lds, const Gemm g, const Sched& S, const Epi& E) {
    const int tid = threadIdx.x, wid = __builtin_amdgcn_readfirstlane(tid >> 6), lane = tid & 63, wr = wid >> 2, wc = wid & 3, fr = lane & 15, fq = lane >> 4;
    const int K = g.K;
    unsigned voffA[2], voffB[2];
#pragma unroll
    for (int i = 0; i < 2; ++i) { int R, C; stage_rc(tid * 16 + i * 8192, R, C); const int Rb = Epi::PERM ? ((R & ~31) + perm32(R & 31)) : R;
        voffA[i] = (unsigned)(R * K + C) * 2u; voffB[i] = (unsigned)(Rb * K + C) * 2u; }
    const size_t kstep = (size_t)(BK * 2);
    const size_t hstep = (size_t)HALF * K * 2;
    const size_t tstep = 2 * hstep;
    const unsigned ldsw = (unsigned)wid * 1024u;
    const int aoff = lds_byte(wr * 64 + fr, fq * 8), boff = lds_byte(wc * 32 + fr, fq * 8);
#define PG8_SA(b, h) (((b) * 2 + (h)) * HTB)
#define PG8_SB(b, h) ((4 + (b) * 2 + (h)) * HTB)
#define PG8_STAGE(bufoff, gbase, voff) do { _Pragma("unroll") for (int _i = 0; _i < 2; ++_i) \
        __builtin_amdgcn_global_load_lds((const unsigned*)((const char*)(gbase) + (voff)[_i]), (PG8_LAS unsigned*)(lds + (bufoff) + ldsw + _i * 8192), 16, 0, 0); } while (0)
#define PG8_LDA(dst, b, h) do { _Pragma("unroll") for (int m = 0; m < 4; ++m) _Pragma("unroll") for (int k = 0; k < 2; ++k) dst[m][k] = *(const PG8_LAS bf16x8*)(lds + PG8_SA(b, h) + aoff + m * 2048 + k * 1024); } while (0)
#define PG8_LDB(dst, b, h) do { _Pragma("unroll") for (int n = 0; n < 2; ++n) _Pragma("unroll") for (int k = 0; k < 2; ++k) dst[n][k] = *(const PG8_LAS bf16x8*)(lds + PG8_SB(b, h) + boff + n * 2048 + k * 1024); } while (0)
#define PG8_MMA(ai, bj, At, Bt) do { __builtin_amdgcn_s_setprio(1); _Pragma("unroll") for (int m = 0; m < 4; ++m) _Pragma("unroll") for (int n = 0; n < 2; ++n) _Pragma("unroll") for (int k = 0; k < 2; ++k) \
        acc[ai][bj][m][n] = __builtin_amdgcn_mfma_f32_16x16x32_bf16(Bt[n][k], At[m][k], acc[ai][bj][m][n], 0, 0, 0); __builtin_amdgcn_s_setprio(0); } while (0)
#define PG8_WAIT_V(n) asm volatile("s_waitcnt vmcnt(" #n ")" ::: "memory")
#define PG8_WAIT_L(n) asm volatile("s_waitcnt lgkmcnt(" #n ")" ::: "memory")
#define PG8_BAR __builtin_amdgcn_s_barrier()
#define PG8_SCHED __builtin_amdgcn_sched_barrier(0)
    Unit cur, nxt; int ui = 0;
    if (!S.next(0, cur)) return;
    f32x4 acc[2][2][4][2];
#pragma unroll
    for (int a = 0; a < 2; ++a)
#pragma unroll
        for (int b = 0; b < 2; ++b)
#pragma unroll
            for (int m = 0; m < 4; ++m)
#pragma unroll
                for (int n = 0; n < 2; ++n) acc[a][b][m][n] = (f32x4){0.f, 0.f, 0.f, 0.f};
    bf16x8 At[4][2], B0[2][2], B1[2][2];
    const char* cA = (const char*)g.A + (size_t)cur.pm * tstep + (size_t)cur.k0 * 2; const char* cB = (const char*)g.Bt + (size_t)cur.pn * tstep + (size_t)cur.k0 * 2;
    S.a_ready(cur);
    if constexpr (SP2) {
        PG8_STAGE(PG8_SB(0, 0), cB, voffB); PG8_STAGE(PG8_SB(0, 1), cB + hstep, voffB); PG8_STAGE(PG8_SA(0, 0), cA, voffA); PG8_STAGE(PG8_SA(0, 1), cA + hstep, voffA);
        if (wr == 1) PG8_BAR;
        PG8_WAIT_V(2); PG8_BAR;
        PG8_STAGE(PG8_SB(1, 0), cB + kstep, voffB); PG8_STAGE(PG8_SA(1, 0), cA + kstep, voffA); PG8_STAGE(PG8_SB(1, 1), cB + hstep + kstep, voffB);
        PG8_WAIT_V(6); PG8_BAR;
    } else {
        PG8_STAGE(PG8_SB(0, 0), cB, voffB); PG8_STAGE(PG8_SA(0, 0), cA, voffA); PG8_STAGE(PG8_SB(0, 1), cB + hstep, voffB); PG8_STAGE(PG8_SA(0, 1), cA + hstep, voffA);
        if (wr == 1) PG8_BAR;
        PG8_WAIT_V(4); PG8_BAR;
        PG8_STAGE(PG8_SB(1, 0), cB + kstep, voffB); PG8_STAGE(PG8_SA(1, 0), cA + kstep, voffA); PG8_STAGE(PG8_SB(1, 1), cB + hstep + kstep, voffB);
        PG8_WAIT_V(6); PG8_BAR;
    }
    for (;;) {
        const bool has_next = S.next(ui + 1, nxt);
        const char* nA = has_next ? (const char*)g.A + (size_t)nxt.pm * tstep + (size_t)nxt.k0 * 2 : cA; const char* nB = has_next ? (const char*)g.Bt + (size_t)nxt.pn * tstep + (size_t)nxt.k0 * 2 : cB;
        const int nt = cur.nt;
        for (int t = 0; t < nt; t += 2) {
            const bool last = (t == nt - 2);
            const char* a1 = cA + (size_t)(t + 1) * kstep;
            const char* a2 = last ? nA : cA + (size_t)(t + 2) * kstep; const char* b2 = last ? nB : cB + (size_t)(t + 2) * kstep;
            const char* a3 = a2 + kstep; const char* b3 = b2 + kstep;
            if (last && has_next) S.a_ready(nxt);
            if constexpr (SP2) {
            PG8_LDB(B0, 0, 0); PG8_LDB(B1, 0, 1); PG8_SCHED; PG8_LDA(At, 0, 0); PG8_STAGE(PG8_SA(1, 1), a1 + hstep, voffA);
            PG8_WAIT_V(8); PG8_WAIT_L(0); PG8_BAR; PG8_MMA(0, 0, At, B0); PG8_MMA(0, 1, At, B1); PG8_BAR; PG8_SCHED;
            PG8_LDA(At, 0, 1); PG8_STAGE(PG8_SB(0, 0), b2, voffB); PG8_STAGE(PG8_SB(0, 1), b2 + hstep, voffB); PG8_STAGE(PG8_SA(0, 0), a2, voffA);
            PG8_WAIT_V(8); PG8_WAIT_L(0); PG8_BAR; PG8_MMA(1, 0, At, B0); PG8_MMA(1, 1, At, B1); PG8_BAR; PG8_SCHED;
            PG8_LDB(B0, 1, 0); PG8_LDB(B1, 1, 1); PG8_SCHED; PG8_LDA(At, 1, 0); PG8_STAGE(PG8_SA(0, 1), a2 + hstep, voffA);
            PG8_WAIT_V(8); PG8_WAIT_L(0); PG8_BAR; PG8_MMA(0, 0, At, B0); PG8_MMA(0, 1, At, B1); PG8_BAR; PG8_SCHED;
            PG8_LDA(At, 1, 1); PG8_STAGE(PG8_SB(1, 0), b3, voffB); PG8_STAGE(PG8_SB(1, 1), b3 + hstep, voffB); PG8_STAGE(PG8_SA(1, 0), a3, voffA);
            PG8_WAIT_V(8); PG8_WAIT_L(0); PG8_BAR; PG8_MMA(1, 0, At, B0); PG8_MMA(1, 1, At, B1); PG8_BAR; PG8_SCHED;
            } else {
            PG8_LDB(B0, 0, 0); PG8_SCHED; PG8_LDA(At, 0, 0); PG8_STAGE(PG8_SA(1, 1), a1 + hstep, voffA);
            PG8_WAIT_L(8); PG8_BAR; PG8_WAIT_L(0); PG8_MMA(0, 0, At, B0); PG8_BAR; PG8_SCHED;
            PG8_LDB(B1, 0, 1); PG8_STAGE(PG8_SB(0, 0), b2, voffB);
            PG8_BAR; PG8_WAIT_L(0); PG8_MMA(0, 1, At, B1); PG8_BAR;
            PG8_LDA(At, 0, 1); PG8_STAGE(PG8_SA(0, 0), a2, voffA);
            PG8_BAR; PG8_WAIT_L(0); PG8_MMA(1, 0, At, B0); PG8_BAR; PG8_SCHED;
            PG8_STAGE(PG8_SB(0, 1), b2 + hstep, voffB);
            PG8_WAIT_V(6); PG8_BAR; PG8_MMA(1, 1, At, B1); PG8_BAR;
            PG8_LDB(B0, 1, 0); PG8_SCHED; PG8_LDA(At, 1, 0); PG8_STAGE(PG8_SA(0, 1), a2 + hstep, voffA);
            PG8_WAIT_L(8); PG8_BAR; PG8_WAIT_L(0); PG8_MMA(0, 0, At, B0); PG8_BAR; PG8_SCHED;
            PG8_LDB(B1, 1, 1); PG8_STAGE(PG8_SB(1, 0), b3, voffB);
            PG8_BAR; PG8_WAIT_L(0); PG8_MMA(0, 1, At, B1); PG8_BAR;
            PG8_LDA(At, 1, 1); PG8_STAGE(PG8_SA(1, 0), a3, voffA);
            PG8_BAR; PG8_WAIT_L(0); PG8_MMA(1, 0, At, B0); PG8_BAR; PG8_SCHED;
            PG8_STAGE(PG8_SB(1, 1), b3 + hstep, voffB);
            PG8_WAIT_V(6); PG8_BAR; PG8_MMA(1, 1, At, B1); PG8_BAR;
            }
        }
        if constexpr (ALIGN_EPI) { if (wr == 0) PG8_BAR; }
        if constexpr (!Epi::AFTER_DRAIN) { E(acc, cur, wr, wc, fr, fq); S.done(cur); }
        if (!has_next) break;
#pragma unroll
        for (int a = 0; a < 2; ++a)
#pragma unroll
            for (int b = 0; b < 2; ++b)
#pragma unroll
                for (int m = 0; m < 4; ++m)
#pragma unroll
                    for (int n = 0; n < 2; ++n) acc[a][b][m][n] = (f32x4){0.f, 0.f, 0.f, 0.f};
        cur = nxt; cA = nA; cB = nB; ++ui;
        if constexpr (ALIGN_EPI) { if (wr == 1) PG8_BAR; }
    }
    PG8_WAIT_V(0);
    if constexpr (!ALIGN_EPI) { if (wr == 0) PG8_BAR; }
    PG8_BAR;
    if constexpr (Epi::AFTER_DRAIN) { E.fused(acc, cur, wr, wc, fr, fq, lds, wid, lane); S.done(cur); }
#undef PG8_SA
#undef PG8_SB
#undef PG8_STAGE
#undef PG8_LDA
#undef PG8_LDB
#undef PG8_MMA
#undef PG8_WAIT_V
#undef PG8_WAIT_L
#undef PG8_BAR
#undef PG8_SCHED
}
}

constexpr int NWAVES = 8, NTHR = NWAVES * 64;
constexpr int DM = 4096, TP = 8192, NS = 128, MROWS = TP + NS, MPAD = 8448;
constexpr int INW = 11296, INP = 11520;
constexpr int OFF_K = 2048, OFF_V = 2560, OFF_PRE = 3072, OFF_Z = 9216, OFF_AB = 11264;
constexpr int CONVD = 6144, FF = 11008, NGU = 2 * FF;
constexpr int NCHUNK = 128, NITEM = 16 * NCHUNK;
constexpr float ALPHA = 1.189207115002721f;
constexpr float LN_EPS = 1e-5f, RMS_EPS = 1e-6f, LOG2E = 1.4426950408889634f;
constexpr float QSCALE = 0.125f * LOG2E;
constexpr size_t O_Y = 0, O_PK = 34078720, O_PV = 34144256, O_PC = 34209792, O_PD = 34228224, O_SK = 34490368, O_SV = 42878976, O_SC = 51267584, O_SD = 53626880, O_END = 87181312;

constexpr size_t MiB = 1u << 20;
constexpr size_t WS_CTL = 0, CTL_ZERO_BYTES = 1 * MiB;
constexpr size_t WS_BIASP = 1 * MiB;
constexpr size_t WS_ROPE = 2 * MiB;
constexpr size_t WS_AB = 5 * MiB;
constexpr size_t WS_GB = 6 * MiB + 512 * 1024;
constexpr size_t WS_GL = 7 * MiB + 640 * 1024;
constexpr size_t WS_SQA = 8 * MiB, WS_SQD = 9 * MiB, WS_SKD = 10 * MiB, WS_SVD = 11 * MiB;
constexpr size_t WS_WOUT = 12 * MiB, WS_WGU = 44 * MiB, WS_WDN = 216 * MiB, WS_WIN = 302 * MiB;
constexpr size_t WS_QB = 302 * MiB, WS_KB = 334 * MiB;
constexpr size_t WS_XB = 392 * MiB;
constexpr size_t WS_PROJ = 458 * MiB;
constexpr size_t WS_QH = 644 * MiB, WS_KH = 676 * MiB, WS_VH = 708 * MiB;
constexpr size_t WS_ST = 644 * MiB, WS_UNT = 708 * MiB;
constexpr size_t WS_CWN = 740 * MiB, WS_CQD = 772 * MiB, WS_CKD = 804 * MiB, WS_CAT = 836 * MiB, WS_CU = 852 * MiB;
constexpr size_t WS_FFN = 644 * MiB;
constexpr size_t WS_T2B = 526 * MiB;
constexpr size_t WS_SLAB = 916 * MiB;
constexpr size_t WS_END = 948 * MiB;
static_assert(WS_WIN + (size_t)INP * DM * 2 <= WS_XB && WS_XB + (size_t)MPAD * DM * 2 <= WS_PROJ && WS_PROJ + (size_t)MPAD * INP * 2 <= WS_QH && WS_CU + (size_t)NITEM * 64 * 128 * 4 <= WS_END && WS_FFN + (size_t)MPAD * FF * 2 <= WS_END, "ws map");
static_assert(WS_WGU + (size_t)NGU * DM * 2 <= WS_WDN && WS_WDN + (size_t)DM * FF * 2 <= WS_WIN && WS_ROPE + 8193 * 32 * 8 <= WS_AB && WS_AB + (size_t)MPAD * 32 * 4 <= WS_GB && WS_GB + TP * 32 * 4 <= WS_GL, "ws map 2");
constexpr int CW_TMO = 0, CW_CODE = 1, CW_BAR = 4096, CW_QATT = 16384, CW_QSMP = 16384 + 64, CW_QCV = 16384 + 1024, CW_XRANK = 32768;

constexpr int RING_OFF = 0, RING_BYTES = 147456, LDSCTL_OFF = RING_BYTES, MISC_OFF = LDSCTL_OFF + 320, LDS_BYTES = 163840;
#define GAS __attribute__((address_space(1)))
#define LAS __attribute__((address_space(3)))
typedef unsigned short bf16;
typedef unsigned v4u __attribute__((ext_vector_type(4)));
typedef float f32x4 __attribute__((ext_vector_type(4)));
typedef short bf16x8 __attribute__((ext_vector_type(8)));
typedef GAS unsigned gu32;
typedef GAS unsigned long long gu64;
#define RLX_AGENT __ATOMIC_RELAXED, __HIP_MEMORY_SCOPE_AGENT
#define LDS_WAIT() asm volatile("s_waitcnt lgkmcnt(0)" ::: "memory")
#define VM_WAIT() asm volatile("s_waitcnt vmcnt(0)" ::: "memory")
__device__ __forceinline__ unsigned long long rt() { return __builtin_amdgcn_s_memrealtime(); }
__device__ __forceinline__ unsigned f2bf(float f) { unsigned u = __builtin_bit_cast(unsigned, f); return (u + 0x7fffu + ((u >> 16) & 1u)) >> 16; }
__device__ __forceinline__ unsigned pk2(float lo, float hi) { return f2bf(lo) | (f2bf(hi) << 16); }

#define XB_TMO      128
#define XB_XCNT(j)  (256  + 64 * (j))
#define XB_XSUB(j)  (1280 + 64 * (j))
#define XB_XGEN(j)  (2304 + 64 * (j))
#define XB_TOP      3328
#define XB_TOPGEN   3392
#define XCD_BAR_WORDS 3456
#define XB_SPIN_CAP (1u << 18)

__device__ __forceinline__ unsigned xb_ld(unsigned* p)              { return __hip_atomic_load(p, __ATOMIC_RELAXED, __HIP_MEMORY_SCOPE_AGENT); }
__device__ __forceinline__ unsigned xb_add(unsigned* p, unsigned v) { return __hip_atomic_fetch_add(p, v, __ATOMIC_RELAXED, __HIP_MEMORY_SCOPE_AGENT); }
__device__ __forceinline__ unsigned xb_xcc_id() { return (unsigned)__builtin_amdgcn_s_getreg((3 << 11) | 20) & 0xFu; }
#define XB_SPIN(cond, bar) do { unsigned _sp = 0; while (cond) { __builtin_amdgcn_s_sleep(1); \
    if ((++_sp & 255u) == 0u) { if (xb_ld(&(bar)[XB_TMO])) break; if (_sp > XB_SPIN_CAP) { atomicAdd(&(bar)[XB_TMO], 1u); break; } } } } while (0)

struct XcdBarrier {
    unsigned* bar; unsigned x;
    volatile LAS unsigned* st;
};

__device__ __forceinline__ XcdBarrier xcd_barrier_post(unsigned* bar, volatile LAS unsigned* st) {
    XcdBarrier b; b.bar = bar; b.x = xb_xcc_id(); b.st = st;
    if (threadIdx.x == 0) (void)xb_add(&bar[XB_XCNT(b.x)], 1u);
    return b;
}
__device__ __forceinline__ void xcd_barrier_complete(unsigned* bar, unsigned x, unsigned& nloc, unsigned& nx) {
    const unsigned G = gridDim.x * gridDim.y * gridDim.z;
    unsigned sum, cnt, mine, sp = 0u;
    for (;;) {
        sum = 0u; cnt = 0u; mine = 0u;
#pragma unroll
        for (unsigned j = 0; j < 16; ++j) { const unsigned c = xb_ld(&bar[XB_XCNT(j)]); sum += c; cnt += (c > 0u) ? 1u : 0u; mine = (j == x) ? c : mine; }
        if (sum == G) break;
        __builtin_amdgcn_s_sleep(1);
        if ((++sp & 255u) == 0u) { if (xb_ld(&bar[XB_TMO])) break; if (sp > XB_SPIN_CAP) { atomicAdd(&bar[XB_TMO], 1u); break; } }
    }
    nloc = mine > 0u ? mine : 1u; nx = cnt > 0u ? cnt : 1u;
}

__device__ __forceinline__ void xcd_barrier(const XcdBarrier& b) {
    asm volatile("s_waitcnt vmcnt(0)" ::: "memory");
    __syncthreads();
    if (threadIdx.x == 0) {
        unsigned* bar = b.bar;
        __builtin_amdgcn_s_waitcnt(0);
        unsigned nloc = b.st[0], nx = b.st[1];
        if (nloc == 0u) { xcd_barrier_complete(bar, b.x, nloc, nx); b.st[0] = nloc; b.st[1] = nx; }
        const unsigned old = xb_add(&bar[XB_XSUB(b.x)], 1u);
        const unsigned gen = old / nloc;
        if (old + 1u == (gen + 1u) * nloc) {
            __builtin_amdgcn_fence(__ATOMIC_RELEASE, "agent");
            asm volatile("s_waitcnt vmcnt(0)" ::: "memory");
            const unsigned og = xb_add(&bar[XB_TOP], 1u);
            const unsigned tg = og / nx;
            if (og + 1u == (tg + 1u) * nx) xb_add(&bar[XB_TOPGEN], 1u);
            else XB_SPIN(xb_ld(&bar[XB_TOPGEN]) == tg, bar);
            __builtin_amdgcn_fence(__ATOMIC_ACQUIRE, "agent");
            xb_add(&bar[XB_XGEN(b.x)], 1u);
            asm volatile("s_waitcnt vmcnt(0)" ::: "memory");
        } else {
            XB_SPIN(xb_ld(&bar[XB_XGEN(b.x)]) == gen, bar);
            __builtin_amdgcn_fence(__ATOMIC_ACQUIRE, "agent");
            asm volatile("s_waitcnt vmcnt(0)" ::: "memory");
        }
    }
    __syncthreads();
}

typedef float f32x16 __attribute__((ext_vector_type(16)));
typedef float f32x2 __attribute__((ext_vector_type(2)));
typedef unsigned v2u __attribute__((ext_vector_type(2)));
typedef __bf16 bf16x2_t __attribute__((ext_vector_type(2)));
#define DI __device__ __forceinline__
#define MFMA32(a, b, c) __builtin_amdgcn_mfma_f32_32x32x16_bf16((a), (b), (c), 0, 0, 0)
#define MFMA16(a, b, c) __builtin_amdgcn_mfma_f32_16x16x32_bf16((a), (b), (c), 0, 0, 0)
DI unsigned cvtpk(float lo, float hi) { f32x2 v = {lo, hi}; bf16x2_t b = __builtin_convertvector(v, bf16x2_t); return __builtin_bit_cast(unsigned, b); }
DI float bf2f(unsigned short b) { return __uint_as_float((unsigned)b << 16); }
DI float bflo(unsigned w) { return __uint_as_float(w << 16); }
DI float bfhi(unsigned w) { return __uint_as_float(w & 0xffff0000u); }
DI bf16x8 pack8(const f32x4& a, const f32x4& b) { v4u p; p.x = cvtpk(a[0], a[1]); p.y = cvtpk(a[2], a[3]); p.z = cvtpk(b[0], b[1]); p.w = cvtpk(b[2], b[3]); return __builtin_bit_cast(bf16x8, p); }
DI float wave_sum(float v) {
#pragma unroll
    for (int o = 1; o < 64; o <<= 1) v += __shfl_xor(v, o);
    return v;
}
DI float wave_max(float v) {
#pragma unroll
    for (int o = 1; o < 64; o <<= 1) v = fmaxf(v, __shfl_xor(v, o));
    return v;
}
DI float row16_sum(float v) {
    v += __int_as_float(__builtin_amdgcn_update_dpp(0, __float_as_int(v), 0x128, 0xf, 0xf, false));
    v += __int_as_float(__builtin_amdgcn_update_dpp(0, __float_as_int(v), 0x124, 0xf, 0xf, false));
    v += __int_as_float(__builtin_amdgcn_update_dpp(0, __float_as_int(v), 0x122, 0xf, 0xf, false));
    v += __int_as_float(__builtin_amdgcn_update_dpp(0, __float_as_int(v), 0x121, 0xf, 0xf, false));
    return v;
}
DI float silu_f(float x) { return x * __builtin_amdgcn_rcpf(1.0f + __builtin_amdgcn_exp2f(-LOG2E * x)); }
DI float silu_acc(float x) { return x / (1.0f + __expf(-x)); }
DI int crow32(int r, int hl) { return (r & 3) + 8 * (r >> 2) + 4 * hl; }

__constant__ float ROPE_HI[32] = {1.591549367e-01f, 1.193493679e-01f, 8.949939907e-02f, 6.711508334e-02f, 5.032921210e-02f, 3.774158657e-02f, 2.830219641e-02f, 2.122365311e-02f, 1.591549441e-02f, 1.193493698e-02f, 8.949940093e-03f, 6.711508147e-03f, 5.032921210e-03f, 3.774158424e-03f, 2.830219688e-03f, 2.122365171e-03f, 1.591549488e-03f, 1.193493721e-03f, 8.949940093e-04f, 6.711508031e-04f, 5.032921326e-04f, 3.774158540e-04f, 2.830219455e-04f, 2.122365258e-04f, 1.591549371e-04f, 1.193493736e-04f, 8.949940093e-05f, 6.711508468e-05f, 5.032921035e-05f, 3.774158540e-05f, 2.830219637e-05f, 2.122365186e-05f};
__constant__ float ROPE_LO[32] = {6.420638243e-09f, 2.294664903e-09f, 2.542919653e-09f, -3.316028840e-10f, 5.173299289e-12f, -1.848551645e-09f, -5.826552019e-10f, -3.431038786e-10f, -1.029942312e-10f, 4.320196978e-11f, 6.802745173e-11f, 1.531042237e-10f, 5.173298855e-13f, 4.797548470e-11f, -1.048316503e-10f, 1.053879969e-10f, -5.686555046e-11f, -1.896286773e-11f, 6.802744999e-12f, 2.695195456e-11f, -1.158979943e-11f, -6.843983713e-12f, 1.279990003e-11f, 1.807650600e-12f, 5.954976963e-12f, -3.351478166e-12f, 6.802744674e-13f, -1.670379113e-12f, 1.751403167e-12f, -6.843983930e-13f, -5.389994549e-13f, 9.083608431e-13f};

struct Args { const float* in[21]; float* out; unsigned char* ws; int ph_lo, ph_hi, li, pad; };
enum { I_XP = 0, I_XS, I_CK, I_CV, I_SCONV, I_SDELTA, I_WIN, I_BATTN, I_SINKS, I_WCONV, I_ALOG, I_DTB, I_NORMW, I_WOUT, I_LN1G, I_LN1B, I_WGATE, I_WUP, I_WDOWN, I_LN2G, I_LN2B };

template <int MODE> DI int rowmap(int n) { return MODE == 0 ? n : (256 * (n >> 7) + (n & 127) + (MODE == 2 ? 128 : 0)); }
template <int MODE> DI void p0_tile(const float* __restrict__ W, int N, int K, bf16* __restrict__ WT, LAS unsigned short* scr, int kb, int nb, int lane) {
    const int k0 = 64 * kb, n0 = 64 * nb, n = n0 + lane; const bool ok = n < N;
    const float* src = W + (size_t)k0 * N + (ok ? n : 0);
#pragma unroll 32
    for (int kk = 0; kk < 64; ++kk) { const float v = __builtin_nontemporal_load(src + (size_t)kk * N); scr[kk * 66 + lane] = (unsigned short)f2bf(ok ? v : 0.f); }
    LDS_WAIT(); asm volatile("" ::: "memory");
    const int c = lane & 7, nn = lane >> 3;
#pragma unroll
    for (int p = 0; p < 8; ++p) { const int nl = nn + 8 * p, ng = n0 + nl;
        const LAS unsigned short* s = scr + (8 * c) * 66 + nl;
        v4u o; o.x = (unsigned)s[0] | ((unsigned)s[66] << 16); o.y = (unsigned)s[2 * 66] | ((unsigned)s[3 * 66] << 16); o.z = (unsigned)s[4 * 66] | ((unsigned)s[5 * 66] << 16); o.w = (unsigned)s[6 * 66] | ((unsigned)s[7 * 66] << 16);
        if (ng < N) *(v4u*)(WT + (size_t)rowmap<MODE>(ng) * K + k0 + 8 * c) = o; }
    LDS_WAIT(); asm volatile("" ::: "memory");
}
constexpr int CV_T_IN = 64 * 177, CV_T_OUT = 64 * 64, CV_T_G = 64 * 172, CV_T_DN = 172 * 64;
constexpr int CV_T3 = CV_T_OUT + CV_T_DN, CV_T4 = 2 * CV_T_G;
DI void cv_tile3(const Args& A, LAS unsigned short* scr, int r, int lane) {
    if (r < CV_T_OUT) p0_tile<0>(A.in[I_WOUT], DM, DM, (bf16*)(A.ws + WS_WOUT), scr, r / 64, r % 64, lane);
    else { r -= CV_T_OUT; p0_tile<0>(A.in[I_WDOWN], DM, FF, (bf16*)(A.ws + WS_WDN), scr, r / 64, r % 64, lane); }
}
DI void cv_tile4(const Args& A, LAS unsigned short* scr, int r, int lane) {
    if (r < CV_T_G) p0_tile<1>(A.in[I_WGATE], FF, DM, (bf16*)(A.ws + WS_WGU), scr, r / 172, r % 172, lane);
    else { r -= CV_T_G; p0_tile<2>(A.in[I_WUP], FF, DM, (bf16*)(A.ws + WS_WGU), scr, r / 172, r % 172, lane); }
}
DI void cv_pull3(const Args& A, LAS unsigned char* lds, gu32* ctr, int t0, int t1, int wave, int lane) {
    LAS unsigned short* scr = (LAS unsigned short*)(lds + RING_OFF + wave * 8448);
    for (;;) { int b = 0; if (lane == 0) b = (int)__hip_atomic_fetch_add(ctr, 4u, RLX_AGENT); b = t0 + __builtin_amdgcn_readfirstlane(b);
        if (b >= t1) break;
        for (int r = b; r < b + 4 && r < t1; ++r) cv_tile3(A, scr, r, lane); }
}
DI void p0_prologue(const Args& A, LAS unsigned char* lds, int gw, int NGW, int wave, int lane) {
    unsigned char* ws = A.ws;
    LAS unsigned short* scr = (LAS unsigned short*)(lds + RING_OFF + wave * 8448);
    for (int it = gw; it < CV_T_IN + CV_T4; it += NGW) {
        if (it < CV_T4) cv_tile4(A, scr, it, lane);
        else { const int r = it - CV_T4; p0_tile<0>(A.in[I_WIN], INW, DM, (bf16*)(ws + WS_WIN), scr, r / 177, r % 177, lane); } }
    for (int m = gw; m < MPAD + (INP - INW); m += NGW) {
        if (m < MPAD) {
            v2u* o = (v2u*)((bf16*)(ws + WS_XB) + (size_t)m * DM) + lane;
            if (m < MROWS) { const f32x4* xr = (const f32x4*)(m < TP ? A.in[I_XP] + (size_t)m * DM : A.in[I_XS] + (size_t)(m - TP) * DM) + lane;
#pragma unroll
                for (int j = 0; j < 16; ++j) { const f32x4 v = __builtin_nontemporal_load(xr + 64 * j); v2u w; w.x = cvtpk(v[0], v[1]); w.y = cvtpk(v[2], v[3]); o[64 * j] = w; } }
            else {
#pragma unroll 8
                for (int j = 0; j < 16; ++j) o[64 * j] = (v2u){0u, 0u}; }
        } else {
            v4u* o = (v4u*)((bf16*)(ws + WS_WIN) + (size_t)(INW + (m - MPAD)) * DM) + lane;
#pragma unroll
            for (int j = 0; j < 8; ++j) o[64 * j] = (v4u){0u, 0u, 0u, 0u};
        }
    }
    const int gt = gw * 64 + lane, NGT = NGW * 64;
    for (int i = gt; i < INP; i += NGT) ((float*)(ws + WS_BIASP))[i] = i < 3072 ? A.in[I_BATTN][i] : 0.f;
    for (int i = gt; i < 8193 * 32; i += NGT) { const int pos = i >> 5, f = i & 31; const float p = (float)pos, hi = ROPE_HI[f];
        const float r0 = p * hi, e0 = __builtin_fmaf(p, hi, -r0) + p * ROPE_LO[f]; float fr = r0 - __builtin_floorf(r0) + e0;
        f32x2 cs; cs.x = __builtin_amdgcn_cosf(fr); cs.y = __builtin_amdgcn_sinf(fr); ((f32x2*)(ws + WS_ROPE))[i] = cs; }
}

DI void p2_token(const Args& A, int row, int lane) {
    unsigned char* ws = A.ws; float* out = A.out;
    const bool smp = row >= TP; const int n = row - TP; const int pos = smp ? TP : row;
    const bf16* pr = (const bf16*)(ws + WS_PROJ) + (size_t)row * INP;
    const int part = lane & 3, hs = lane >> 2, d0 = 8 * part;
    f32x4 cs[4];
    { const f32x4* tp = (const f32x4*)((const float*)(ws + WS_ROPE) + ((size_t)pos * 32 + d0) * 2);
#pragma unroll
      for (int j = 0; j < 4; ++j) cs[j] = tp[j]; }
#pragma unroll
    for (int ps = 0; ps < 3; ++ps) { const int hh = 16 * ps + hs;
        if (hh < 40) {
            const v4u a = *(const v4u*)(pr + hh * 64 + d0), b = *(const v4u*)(pr + hh * 64 + 32 + d0);
            float x1[8], x2[8], o1[8], o2[8];
#pragma unroll
            for (int j = 0; j < 4; ++j) { x1[2 * j] = bflo(a[j]); x1[2 * j + 1] = bfhi(a[j]); x2[2 * j] = bflo(b[j]); x2[2 * j + 1] = bfhi(b[j]); }
#pragma unroll
            for (int j = 0; j < 8; ++j) { const float c = cs[j >> 1][(j & 1) * 2], s = cs[j >> 1][(j & 1) * 2 + 1]; o1[j] = x1[j] * c - x2[j] * s; o2[j] = x2[j] * c + x1[j] * s; }
            if (hh < 32) {
                if (!smp) { bf16* q = (bf16*)(ws + WS_QB) + (size_t)row * 2048 + hh * 64 + d0;
                    v4u w1, w2;
#pragma unroll
                    for (int j = 0; j < 4; ++j) { w1[j] = cvtpk(o1[2 * j] * QSCALE, o1[2 * j + 1] * QSCALE); w2[j] = cvtpk(o2[2 * j] * QSCALE, o2[2 * j + 1] * QSCALE); }
                    *(v4u*)q = w1; *(v4u*)(q + 32) = w2;
                } else { float* q = (float*)(ws + WS_SQA) + (size_t)n * 2048 + hh * 64 + d0;
#pragma unroll
                    for (int j = 0; j < 8; ++j) { q[j] = o1[j] * QSCALE; q[32 + j] = o2[j] * QSCALE; } }
            } else { const int kvh = hh - 32;
                if (!smp) { bf16* k = (bf16*)(ws + WS_KB) + (size_t)row * 512 + kvh * 64 + d0;
                    v4u w1, w2;
#pragma unroll
                    for (int j = 0; j < 4; ++j) { w1[j] = cvtpk(o1[2 * j], o1[2 * j + 1]); w2[j] = cvtpk(o2[2 * j], o2[2 * j + 1]); }
                    *(v4u*)k = w1; *(v4u*)(k + 32) = w2; }
                if (smp || row >= TP - 128) { float* k = smp ? out + O_SK + ((size_t)n * 128 + 127) * 512 + kvh * 64 + d0 : out + O_PK + (size_t)(row - (TP - 128)) * 512 + kvh * 64 + d0;
#pragma unroll
                    for (int j = 0; j < 8; ++j) { k[j] = o1[j]; k[32 + j] = o2[j]; } }
            }
        }
    }
    if (smp || row >= TP - 128) { float* v = smp ? out + O_SV + ((size_t)n * 128 + 127) * 512 : out + O_PV + (size_t)(row - (TP - 128)) * 512;
        const v4u a = *(const v4u*)(pr + OFF_V + 8 * lane);
#pragma unroll
        for (int j = 0; j < 4; ++j) { v[8 * lane + 2 * j] = bflo(a[j]); v[8 * lane + 2 * j + 1] = bfhi(a[j]); } }
    if (smp && lane < 16) {   const float* ab = (const float*)(ws + WS_AB) + (size_t)row * 32; const float a = ab[lane] + A.in[I_DTB][lane], b = ab[16 + lane];
        const float sp = a > 20.f ? a : log1pf(expf(a)); const float g = -expf(A.in[I_ALOG][lane]) * sp; const float be = 1.0f / (1.0f + expf(-b));
        if (!smp) { float* gb = (float*)(ws + WS_GB) + (size_t)row * 32; gb[lane] = g; gb[16 + lane] = be; }
        else { float* gs = (float*)(ws + WS_SQA); (void)gs; float* gb2 = (float*)(ws + WS_GL) + 4096 + (size_t)n * 32; gb2[lane] = g; gb2[16 + lane] = be; } }
}

DI void p2_conv4(const Args& A, int grp, int ps, int lane) {
    unsigned char* ws = A.ws; float* out = A.out;
    const int t0 = 4 * grp, c0 = 512 * ps + 8 * lane;
    const bf16* pr = (const bf16*)(ws + WS_PROJ) + OFF_PRE + c0;
    v4u xr[7];
#pragma unroll
    for (int j = 0; j < 7; ++j) { const int r = t0 - 3 + j; xr[j] = r >= 0 ? *(const v4u*)(pr + (size_t)r * INP) : (v4u){0u, 0u, 0u, 0u}; }
    f32x4 w[4][2];
#pragma unroll
    for (int j = 0; j < 4; ++j) { const f32x4* wp = (const f32x4*)(A.in[I_WCONV] + (size_t)j * CONVD + c0); w[j][0] = wp[0]; w[j][1] = wp[1]; }
    float x[7][8];
#pragma unroll
    for (int j = 0; j < 7; ++j)
#pragma unroll
        for (int e = 0; e < 4; ++e) { x[j][2 * e] = bflo(xr[j][e]); x[j][2 * e + 1] = bfhi(xr[j][e]); }
    const int cc = (ps & 3) * 512 + 8 * lane;
    bf16* dst = (bf16*)(ws + (ps < 4 ? WS_QH : (ps < 8 ? WS_KH : WS_VH))) + (size_t)t0 * 2048 + cc;
#pragma unroll
    for (int t = 0; t < 4; ++t) { float y[8]; float ss = 0.f;
#pragma unroll
        for (int e = 0; e < 8; ++e) { float a = 0.f;
#pragma unroll
            for (int j = 0; j < 4; ++j) a += w[j][e >> 2][e & 3] * x[t + j][e];
            y[e] = silu_acc(a); ss += y[e] * y[e]; }
        if (ps < 8) { ss = row16_sum(ss);
            const float rn = (1.0f / sqrtf(ss + RMS_EPS)) * (ps < 4 ? 0.08838834764831845f : 1.0f);
#pragma unroll
            for (int e = 0; e < 8; ++e) y[e] *= rn; }
        v4u o;
#pragma unroll
        for (int e = 0; e < 4; ++e) o[e] = cvtpk(y[2 * e], y[2 * e + 1]);
        *(v4u*)(dst + (size_t)t * 2048) = o;
        if (t0 + t >= TP - 3) { float* d = out + O_PC + (size_t)(t0 + t - (TP - 3)) * CONVD + c0;
            *(f32x4*)d = (f32x4){x[t + 3][0], x[t + 3][1], x[t + 3][2], x[t + 3][3]}; *(f32x4*)(d + 4) = (f32x4){x[t + 3][4], x[t + 3][5], x[t + 3][6], x[t + 3][7]}; }
    }
}
DI void p2_convs(const Args& A, int n, int ps, int lane) {
    unsigned char* ws = A.ws; float* out = A.out;
    const int c0 = 512 * ps + 8 * lane;
    float x[4][8];
#pragma unroll
    for (int j = 0; j < 3; ++j) { const f32x4* sp = (const f32x4*)(A.in[I_SCONV] + ((size_t)n * 3 + j) * CONVD + c0); const f32x4 s0 = sp[0], s1 = sp[1];
#pragma unroll
        for (int e = 0; e < 4; ++e) { x[j][e] = s0[e]; x[j][4 + e] = s1[e]; } }
    { const v4u a = *(const v4u*)((const bf16*)(ws + WS_PROJ) + (size_t)(TP + n) * INP + OFF_PRE + c0);
#pragma unroll
      for (int e = 0; e < 4; ++e) { x[3][2 * e] = bflo(a[e]); x[3][2 * e + 1] = bfhi(a[e]); } }
    float y[8]; float ss = 0.f;
#pragma unroll
    for (int e = 0; e < 8; ++e) y[e] = 0.f;
#pragma unroll
    for (int j = 0; j < 4; ++j) { const f32x4* wp = (const f32x4*)(A.in[I_WCONV] + (size_t)j * CONVD + c0); const f32x4 w0 = wp[0], w1 = wp[1];
#pragma unroll
        for (int e = 0; e < 4; ++e) { y[e] += w0[e] * x[j][e]; y[4 + e] += w1[e] * x[j][4 + e]; } }
#pragma unroll
    for (int e = 0; e < 8; ++e) { y[e] = silu_acc(y[e]); ss += y[e] * y[e]; }
    if (ps < 8) { ss = row16_sum(ss);
        const float rn = (1.0f / sqrtf(ss + RMS_EPS)) * (ps < 4 ? 0.08838834764831845f : 1.0f);
#pragma unroll
        for (int e = 0; e < 8; ++e) y[e] *= rn; }
    float* dst = (float*)(ws + (ps < 4 ? WS_SQD : (ps < 8 ? WS_SKD : WS_SVD))) + (size_t)n * 2048 + (ps & 3) * 512 + 8 * lane;
    *(f32x4*)dst = (f32x4){y[0], y[1], y[2], y[3]}; *(f32x4*)(dst + 4) = (f32x4){y[4], y[5], y[6], y[7]};
    float* d = out + O_SC + (size_t)n * 3 * CONVD + c0;
#pragma unroll
    for (int j = 0; j < 3; ++j) { *(f32x4*)(d + (size_t)j * CONVD) = (f32x4){x[j + 1][0], x[j + 1][1], x[j + 1][2], x[j + 1][3]}; *(f32x4*)(d + (size_t)j * CONVD + 4) = (f32x4){x[j + 1][4], x[j + 1][5], x[j + 1][6], x[j + 1][7]}; }
}

constexpr size_t WS_GBS = WS_GL + 16384;

DI void p3_pair(const Args& A, int it0, LAS unsigned char* ldsw, int tid, int wave, int lane) {
    unsigned char* ws = A.ws;
    const int half = tid >> 8, t = tid & 255, w4 = wave & 3, it = it0 + half;
    const int hh = it >> 7, ck = it & 127, t0 = ck * 64;
    LAS unsigned char* lds = ldsw + half * 53248;
    LAS unsigned short* KH = (LAS unsigned short*)(lds);
    LAS unsigned short* QH = (LAS unsigned short*)(lds + 17408);
    LAS float* AMT = (LAS float*)(lds + 34816);
    LAS float* CUM = (LAS float*)(lds + 52224);
    LAS float* BET = CUM + 64;
    {   const int g4 = t >> 4, ch = t & 15;
#pragma unroll 1
        for (int which = 0; which < 2; ++which) {
            const bf16* pr = (const bf16*)(ws + WS_PROJ) + OFF_PRE + which * 2048 + hh * 128 + 8 * ch; const float* wc = A.in[I_WCONV] + which * 2048 + hh * 128 + 8 * ch;
            v4u xr[7];
#pragma unroll
            for (int j = 0; j < 7; ++j) { const int row = t0 + 4 * g4 - 3 + j; xr[j] = row >= 0 ? *(const v4u*)(pr + (size_t)row * INP) : (v4u){0u, 0u, 0u, 0u}; }
            f32x4 w[4][2];
#pragma unroll
            for (int j = 0; j < 4; ++j) { w[j][0] = *(const f32x4*)(wc + (size_t)j * CONVD); w[j][1] = *(const f32x4*)(wc + (size_t)j * CONVD + 4); }
            LAS unsigned short* dst = (which ? KH : QH) + (4 * g4) * 136 + ch * 8;
#pragma unroll
            for (int tt = 0; tt < 4; ++tt) { float y[8]; float ss = 0.f;
#pragma unroll
                for (int e = 0; e < 8; ++e) { float a = 0.f;
#pragma unroll
                    for (int j = 0; j < 4; ++j) { const unsigned wd = xr[tt + j][e >> 1]; a += w[j][e >> 2][e & 3] * ((e & 1) ? bfhi(wd) : bflo(wd)); }
                    y[e] = silu_acc(a); ss += y[e] * y[e]; }
                ss = row16_sum(ss);
                const float rn = (1.0f / sqrtf(ss + RMS_EPS)) * (which == 0 ? 0.08838834764831845f : 1.0f);
                v4u o;
#pragma unroll
                for (int e = 0; e < 4; ++e) o[e] = cvtpk(y[2 * e] * rn, y[2 * e + 1] * rn);
                *(LAS v4u*)(dst + tt * 136) = o;
                if (ck == NCHUNK - 1 && 4 * g4 + tt >= 61) { float* d = A.out + O_PC + (size_t)(4 * g4 + tt - 61) * CONVD + which * 2048 + hh * 128 + 8 * ch; const v4u rw = xr[tt + 3];
                    *(f32x4*)d = (f32x4){bflo(rw[0]), bfhi(rw[0]), bflo(rw[1]), bfhi(rw[1])}; *(f32x4*)(d + 4) = (f32x4){bflo(rw[2]), bfhi(rw[2]), bflo(rw[3]), bfhi(rw[3])}; }
            }
        }
    }
    __builtin_amdgcn_sched_barrier(0);
    float x[64];
    if (t >= 128) { const int c = t - 128; const bf16* pv = (const bf16*)(ws + WS_PROJ) + OFF_PRE + 4096 + hh * 128 + c; const float* wc = A.in[I_WCONV] + 4096 + hh * 128 + c;
        const float w0 = wc[0], w1 = wc[CONVD], w2 = wc[2 * CONVD], w3 = wc[3 * CONVD];
        float e0, e1, e2;
        { const int r0 = t0 - 3; e0 = r0 >= 0 ? bf2f(pv[(size_t)r0 * INP]) : 0.f; e1 = r0 + 1 >= 0 ? bf2f(pv[(size_t)(r0 + 1) * INP]) : 0.f; e2 = r0 + 2 >= 0 ? bf2f(pv[(size_t)(r0 + 2) * INP]) : 0.f; }
#pragma unroll
        for (int i = 0; i < 64; ++i) x[i] = bf2f(pv[(size_t)(t0 + i) * INP]);
        if (ck == NCHUNK - 1) { float* d = A.out + O_PC + 4096 + hh * 128 + c; d[0] = x[61]; d[CONVD] = x[62]; d[2 * CONVD] = x[63]; }
#pragma unroll
        for (int i = 63; i >= 0; --i) { const float a = i >= 3 ? x[i - 3] : (i == 2 ? e2 : (i == 1 ? e1 : e0)), b = i >= 2 ? x[i - 2] : (i == 1 ? e2 : e1), cc2 = i >= 1 ? x[i - 1] : e2;
            x[i] = silu_acc(w0 * a + w1 * b + w2 * cc2 + w3 * x[i]); }
    }
    if (t < 64) {
        const float* ab = (const float*)(ws + WS_AB) + (size_t)(t0 + t) * 32; const float a = ab[hh] + A.in[I_DTB][hh], bb = ab[16 + hh];
        const float sp = a > 20.f ? a : log1pf(expf(a)); float c = -expf(A.in[I_ALOG][hh]) * sp;
#pragma unroll
        for (int o = 1; o < 64; o <<= 1) { const float tt = __shfl_up(c, o); if (lane >= o) c += tt; }
        CUM[t] = c; BET[t] = 1.0f / (1.0f + expf(-bb)); }
    __syncthreads();
    {
        const int ti = (w4 >> 1) & 1, tj = w4 & 1, l31 = lane & 31, hl = lane >> 5;
        const LAS unsigned short* Bs = KH + (32 * tj + l31) * 136 + 8 * hl;
        const int j = 32 * tj + l31; const float cj = CUM[j];
        bf16* att = (bf16*)(ws + WS_CAT) + (size_t)it * 4096;
#pragma unroll
        for (int which = 0; which < 2; ++which) {
            const LAS unsigned short* As = (which ? QH : KH) + (32 * ti + l31) * 136 + 8 * hl;
            f32x16 xx;
#pragma unroll
            for (int r = 0; r < 16; ++r) xx[r] = 0.f;
#pragma unroll
            for (int s = 0; s < 8; ++s) { const bf16x8 a = *(const LAS bf16x8*)(As + 16 * s), b = *(const LAS bf16x8*)(Bs + 16 * s); xx = MFMA32(a, b, xx); }
#pragma unroll
            for (int r = 0; r < 16; ++r) { const int i = 32 * ti + crow32(r, hl); const float dec = __expf(fminf(CUM[i] - cj, 0.f));
                if (which == 0) { if (i > j) AMT[j * 68 + i] = BET[i] * xx[r] * dec; }
                else { const float v = i >= j ? xx[r] * dec : 0.f; att[i * 64 + j] = (bf16)f2bf(v); } }
        }
    }
    __syncthreads();
    if (t < 128) { const int c = t; const float cl = CUM[63];
        bf16* kd = (bf16*)(ws + WS_CKD) + (size_t)it * 8192 + c * 64;
#pragma unroll
        for (int g = 0; g < 8; ++g) { float kv[8];
#pragma unroll
            for (int e = 0; e < 8; ++e) { const int tt = 8 * g + e; const float k = bf2f(KH[tt * 136 + c]); const float cu = CUM[tt]; kv[e] = k * __expf(cl - cu); x[tt] = k * BET[tt] * __expf(cu); }
            v4u w; w.x = cvtpk(kv[0], kv[1]); w.y = cvtpk(kv[2], kv[3]); w.z = cvtpk(kv[4], kv[5]); w.w = cvtpk(kv[6], kv[7]); *(v4u*)(kd + 8 * g) = w; }
    } else {
#pragma unroll
        for (int i = 0; i < 64; ++i) x[i] *= BET[i];
    }
#pragma unroll
    for (int j = 0; j < 63; ++j) { const float xj = x[j];
#pragma unroll
        for (int a4 = (j + 1) / 4; a4 < 16; ++a4) { const f32x4 av = *(const LAS f32x4*)(AMT + j * 68 + 4 * a4);
#pragma unroll
            for (int e = 0; e < 4; ++e) { const int i = 4 * a4 + e; if (i > j) x[i] -= av[e] * xj; } } }
    if (t < 128) { bf16* wn = (bf16*)(ws + WS_CWN) + (size_t)it * 8192 + t;
#pragma unroll
        for (int i = 0; i < 64; ++i) wn[i * 128] = (bf16)f2bf(-x[i]);
    } else { float* u = (float*)(ws + WS_CU) + (size_t)it * 8192 + (t - 128);
#pragma unroll
        for (int i = 0; i < 64; ++i) u[i * 128] = x[i];
    }
    {
        bf16* qd = (bf16*)(ws + WS_CQD) + (size_t)it * 8192;
#pragma unroll
        for (int p = 0; p < 4; ++p) { const int c = t + 256 * p, r = c >> 4, ch = c & 15; const float ga = __expf(CUM[r]);
            const v4u a = *(const LAS v4u*)(QH + r * 136 + ch * 8); v4u w;
#pragma unroll
            for (int e = 0; e < 4; ++e) w[e] = cvtpk(bflo(a[e]) * ga, bfhi(a[e]) * ga);
            *(v4u*)(qd + r * 128 + ch * 8) = w; }
        if (t == 0) ((float*)(ws + WS_GL))[it] = __expf(CUM[63]);
    }
    __syncthreads();
}

DI float rdlane(float v, int l) { return __int_as_float(__builtin_amdgcn_readlane(__float_as_int(v), l)); }
constexpr int SCAN_NCW = 2;
constexpr int SCAN_SLOT = 32768 + 4096 * SCAN_NCW, SCAN_NS = 3, SCAN_PIECES = 8 + SCAN_NCW;
DI void p4_scan_wg(const Args& A, int item, LAS unsigned char* lds, int wave, int lane) {
    unsigned char* ws = A.ws;
#if defined(PROBE_MASK)
    const bool x_nost = A.pad & 16, x_nocomp = A.pad & 32, x_noload = A.pad & 64;
#else
    constexpr bool x_nost = false, x_nocomp = false, x_noload = false;
#endif
    constexpr int NPART = 8 / SCAN_NCW, URB = 64 * SCAN_NCW, UCPR = 4 * SCAN_NCW, URPP = 1024 / URB;
    const int hh = item / NPART, hf = item % NPART;
    const unsigned char* Wn = ws + WS_CWN + (size_t)hh * 128 * 16384; const unsigned char* Kd = ws + WS_CKD + (size_t)hh * 128 * 16384; const unsigned char* U = ws + WS_CU + (size_t)hh * 128 * 32768 + hf * URB;
    if (wave >= 4) {
        const int lj = wave - 4;
        unsigned off[SCAN_PIECES];
#pragma unroll
        for (int i = 0; i < SCAN_PIECES; ++i) { const int p = lj + 4 * i;
            if (i < 4) { const int row = 4 * p + (lane >> 4), pos = lane & 15, f = (row & 3) | (((row >> 3) & 3) << 2); off[i] = (unsigned)(row * 256 + 16 * (pos ^ f)); }
            else if (i < 8) { const int pp = p - 16, row = 8 * pp + (lane >> 3), pos = lane & 7, f = ((row >> 1) & 1) | (((row >> 3) & 3) << 1); off[i] = (unsigned)(row * 128 + 16 * (pos ^ f)); }
            else { const int pp = p - 32, row = URPP * pp + lane / UCPR, pos = lane % UCPR, f = UCPR >= 8 ? ((row >> 3) & 1) << 2 : 0; off[i] = (unsigned)(row * 512 + 16 * (pos ^ f)); } }
        v4u buf[2][SCAN_PIECES];
#define SCAN_LD(c, R) do { const unsigned char* w_ = Wn + (size_t)(c) * 16384; const unsigned char* k_ = Kd + (size_t)(c) * 16384; const unsigned char* u_ = U + (size_t)(c) * 32768; \
        _Pragma("unroll") for (int i = 0; i < 4; ++i) buf[R][i] = *(const v4u*)(w_ + off[i]); \
        _Pragma("unroll") for (int i = 4; i < 8; ++i) buf[R][i] = *(const v4u*)(k_ + off[i]); \
        _Pragma("unroll") for (int i = 8; i < SCAN_PIECES; ++i) buf[R][i] = *(const v4u*)(u_ + off[i]); } while (0)
#define SCAN_ST(c, R) do { LAS unsigned char* sb_ = lds + ((c) % SCAN_NS) * SCAN_SLOT + 1024 * lj + 16 * lane; \
        _Pragma("unroll") for (int i = 0; i < 4; ++i) *(LAS v4u*)(sb_ + 4096 * i) = buf[R][i]; \
        _Pragma("unroll") for (int i = 4; i < 8; ++i) *(LAS v4u*)(sb_ + 16384 + 4096 * (i - 4)) = buf[R][i]; \
        _Pragma("unroll") for (int i = 8; i < SCAN_PIECES; ++i) *(LAS v4u*)(sb_ + 32768 + 4096 * (i - 8)) = buf[R][i]; } while (0)
        if (x_noload) { for (int b = 0; b < NCHUNK + 1; ++b) { asm volatile("" ::: "memory"); __builtin_amdgcn_s_barrier(); } return; }
        SCAN_LD(0, 0); SCAN_LD(1, 1); SCAN_ST(0, 0); SCAN_LD(2, 0); SCAN_ST(1, 1); SCAN_LD(3, 1);
        asm volatile("s_waitcnt lgkmcnt(0)" ::: "memory"); __builtin_amdgcn_s_barrier(); asm volatile("" ::: "memory");
#pragma unroll 1
        for (int c2 = 0; c2 < NCHUNK; c2 += 2) {
#define SCAN_STEP(u) do { const int ck = c2 + (u); if (ck + 2 < NCHUNK) { SCAN_ST(ck + 2, (u)); if (ck + 4 < NCHUNK) SCAN_LD(ck + 4, (u)); } \
            asm volatile("s_waitcnt lgkmcnt(0)" ::: "memory"); __builtin_amdgcn_s_barrier(); asm volatile("" ::: "memory"); } while (0)
            SCAN_STEP(0); SCAN_STEP(1);
#undef SCAN_STEP
        }
#undef SCAN_LD
#undef SCAN_ST
    } else if (wave >= SCAN_NCW) {
        for (int b = 0; b < NCHUNK + 1; ++b) { asm volatile("" ::: "memory"); __builtin_amdgcn_s_barrier(); }
    } else {
        const int q = lane >> 4, cc = lane & 15, cs = hf * SCAN_NCW + wave;
        const int rslot = 8 * (cc >> 2) + (cc & 3);
        const int fK = ((cc >> 1) & 1) | ((cc >> 2) << 1);
        f32x4 S[8];
#pragma unroll
        for (int m = 0; m < 8; ++m) S[m] = (f32x4){0.f, 0.f, 0.f, 0.f};
        const float* GL = (const float*)(ws + WS_GL) + hh * 128; const float gl0 = GL[lane], gl1 = GL[64 + lane];
        bf16* ST = (bf16*)(ws + WS_ST) + ((size_t)hh * 128 * 128 + cs * 16 + cc) * 128 + 8 * q;
        bf16* UT = (bf16*)(ws + WS_UNT) + ((size_t)hh * 128 * 128 + cs * 16 + cc) * 64 + 8 * q;
        if (x_nocomp) { for (int b = 0; b < NCHUNK + 1; ++b) { asm volatile("" ::: "memory"); __builtin_amdgcn_s_barrier(); } return; }
        asm volatile("s_waitcnt vmcnt(0)" ::: "memory"); __builtin_amdgcn_s_barrier(); asm volatile("" ::: "memory");
#pragma unroll 1
        for (int ck = 0; ck < NCHUNK; ++ck) {
            const LAS unsigned char* sb = lds + (ck % SCAN_NS) * SCAN_SLOT;
            bf16x8 Sb[4];
#pragma unroll
            for (int s = 0; s < 4; ++s) { Sb[s] = pack8(S[2 * s], S[2 * s + 1]); if (!x_nost) *(bf16x8*)(ST + (size_t)ck * 16384 + 32 * s) = Sb[s]; }
            f32x4 P[4];
#pragma unroll
            for (int mt = 0; mt < 4; ++mt) { const int tb = 32 * (mt >> 1) + 8 * q + 4 * (mt & 1);
#pragma unroll
                for (int r = 0; r < 4; ++r) { const int row = tb + r; P[mt][r] = *(const LAS float*)(sb + 32768 + row * URB + 16 * ((4 * wave + (cc >> 2)) ^ (UCPR >= 8 ? ((row >> 3) & 1) << 2 : 0)) + 4 * (cc & 3)); } }
#pragma unroll
            for (int mt = 0; mt < 4; ++mt) { const int row = 32 * (mt >> 1) + 4 * (mt & 1) + rslot;
#pragma unroll
                for (int s = 0; s < 4; ++s) P[mt] = MFMA16(*(const LAS bf16x8*)(sb + row * 256 + 16 * ((4 * s + q) ^ cc)), Sb[s], P[mt]); }
            bf16x8 Ub[2]; Ub[0] = pack8(P[0], P[1]); Ub[1] = pack8(P[2], P[3]);
            if (!x_nost) { *(bf16x8*)(UT + (size_t)ck * 8192) = Ub[0]; *(bf16x8*)(UT + (size_t)ck * 8192 + 32) = Ub[1]; }
            const float gl = rdlane(ck < 64 ? gl0 : gl1, ck & 63);
#pragma unroll
            for (int m = 0; m < 8; ++m) { const int row = 32 * (m >> 1) + 4 * (m & 1) + rslot; S[m] = S[m] * gl;
#pragma unroll
                for (int s = 0; s < 2; ++s) S[m] = MFMA16(*(const LAS bf16x8*)(sb + 16384 + row * 128 + 16 * ((4 * s + q) ^ fK)), Ub[s], S[m]); }
            asm volatile("s_waitcnt lgkmcnt(0)" ::: "memory"); __builtin_amdgcn_s_barrier(); asm volatile("" ::: "memory");
        }
        float* pd = A.out + O_PD + (size_t)hh * 128 * 128 + cs * 16 + cc;
        if (!x_nost)
#pragma unroll
        for (int m = 0; m < 8; ++m) { const int db = 32 * (m >> 1) + 8 * q + 4 * (m & 1);
#pragma unroll
            for (int r = 0; r < 4; ++r) pd[(db + r) * 128] = S[m][r]; }
    }
}

DI void p4_attn(const Args& A, int item, int lane) {
    unsigned char* ws = A.ws;
    const int qt = item >> 5, h = item & 31, kvh = h >> 2, l31 = lane & 31, hl = lane >> 5;
    const int qpos = 32 * qt + l31;
    const bf16* Qb = (const bf16*)(ws + WS_QB) + (size_t)qpos * 2048 + h * 64 + 8 * hl;
    bf16x8 qf[4];
#pragma unroll
    for (int s = 0; s < 4; ++s) qf[s] = *(const bf16x8*)(Qb + 16 * s);
    const float sink2 = A.in[I_SINKS][h] * LOG2E;
    float mx = sink2;
    f32x16 sc[5];
#pragma unroll
    for (int kk = 0; kk < 5; ++kk) { const int kt = qt - 4 + kk;
        f32x16 x;
#pragma unroll
        for (int r = 0; r < 16; ++r) x[r] = 0.f;
        if (kt >= 0) { const bf16* Kb = (const bf16*)(ws + WS_KB) + (size_t)(32 * kt + l31) * 512 + kvh * 64 + 8 * hl;
#pragma unroll
            for (int s = 0; s < 4; ++s) x = MFMA32(*(const bf16x8*)(Kb + 16 * s), qf[s], x); }
#pragma unroll
        for (int r = 0; r < 16; ++r) { const int diff = qpos - (32 * kt + crow32(r, hl)); const bool ok = (kt >= 0) && diff >= 0 && diff < 128; x[r] = ok ? x[r] : -INFINITY; mx = fmaxf(mx, x[r]); }
        sc[kk] = x; }
    mx = fmaxf(mx, __shfl_xor(mx, 32));
    float l = 0.f;
#pragma unroll
    for (int kk = 0; kk < 5; ++kk)
#pragma unroll
        for (int r = 0; r < 16; ++r) { const float p = __builtin_amdgcn_exp2f(sc[kk][r] - mx); sc[kk][r] = p; l += p; }
    l += __shfl_xor(l, 32); l += __builtin_amdgcn_exp2f(sink2 - mx);
    f32x16 o0, o1;
#pragma unroll
    for (int r = 0; r < 16; ++r) { o0[r] = 0.f; o1[r] = 0.f; }
    const bf16* Vb = (const bf16*)(ws + WS_PROJ) + OFF_V + kvh * 64 + l31;
#pragma unroll
    for (int kk = 0; kk < 5; ++kk) { const int kt = qt - 4 + kk;
        if (kt >= 0) {
#pragma unroll
            for (int s = 0; s < 2; ++s) { v4u pw;
#pragma unroll
                for (int e = 0; e < 4; ++e) pw[e] = cvtpk(sc[kk][8 * s + 2 * e], sc[kk][8 * s + 2 * e + 1]);
                const bf16x8 pb = __builtin_bit_cast(bf16x8, pw);
                v4u v0, v1;
#pragma unroll
                for (int e = 0; e < 4; ++e) { const int k0 = 32 * kt + 16 * s + 8 * ((2 * e) >> 2) + 4 * hl + ((2 * e) & 3), k1 = k0 + 1;
                    const bf16* r0 = Vb + (size_t)k0 * INP; const bf16* r1 = Vb + (size_t)k1 * INP;
                    v0[e] = (unsigned)r0[0] | ((unsigned)r1[0] << 16); v1[e] = (unsigned)r0[32] | ((unsigned)r1[32] << 16); }
                o0 = MFMA32(__builtin_bit_cast(bf16x8, v0), pb, o0); o1 = MFMA32(__builtin_bit_cast(bf16x8, v1), pb, o1); } } }
    const float inv = 1.0f / l;
    bf16* mix = (bf16*)(ws + WS_XB) + (size_t)qpos * DM + h * 64 + 4 * hl;
#pragma unroll
    for (int g = 0; g < 4; ++g) { v2u w0, w1; w0.x = cvtpk(o0[4 * g] * inv, o0[4 * g + 1] * inv); w0.y = cvtpk(o0[4 * g + 2] * inv, o0[4 * g + 3] * inv);
        w1.x = cvtpk(o1[4 * g] * inv, o1[4 * g + 1] * inv); w1.y = cvtpk(o1[4 * g + 2] * inv, o1[4 * g + 3] * inv);
        *(v2u*)(mix + 8 * g) = w0; *(v2u*)(mix + 32 + 8 * g) = w1; }
}

DI void p4_sattn(const Args& A, int item, int lane) {
    unsigned char* ws = A.ws;
    const int n = item >> 3, kvh = item & 7;
    const float* ck = A.in[I_CK] + (size_t)n * 128 * 512 + kvh * 64; const float* cv = A.in[I_CV] + (size_t)n * 128 * 512 + kvh * 64;
    float* ok = A.out + O_SK + (size_t)n * 128 * 512 + kvh * 64; float* ov = A.out + O_SV + (size_t)n * 128 * 512 + kvh * 64;
    const float* qs = (const float*)(ws + WS_SQA) + (size_t)n * 2048 + kvh * 256 + lane;
    float qv[4];
#pragma unroll
    for (int hq = 0; hq < 4; ++hq) qv[hq] = qs[hq * 64];
    float sc[4][2];
#pragma unroll
    for (int half = 0; half < 2; ++half) { const int idx = lane + 64 * half;
        const f32x4* src = (const f32x4*)(idx < 127 ? ck + (size_t)(idx + 1) * 512 : ok + (size_t)127 * 512);
        f32x4 kr[16];
#pragma unroll
        for (int c = 0; c < 16; ++c) kr[c] = __builtin_nontemporal_load(src + c);
        if (idx < 127) { f32x4* dst = (f32x4*)(ok + (size_t)idx * 512);
#pragma unroll
            for (int c = 0; c < 16; ++c) __builtin_nontemporal_store(kr[c], dst + c); }
        float s0 = 0.f, s1 = 0.f, s2 = 0.f, s3 = 0.f;
#pragma unroll
        for (int d = 0; d < 64; ++d) { const float kd = kr[d >> 2][d & 3]; s0 += kd * rdlane(qv[0], d); s1 += kd * rdlane(qv[1], d); s2 += kd * rdlane(qv[2], d); s3 += kd * rdlane(qv[3], d); }
        sc[0][half] = s0; sc[1][half] = s1; sc[2][half] = s2; sc[3][half] = s3; }
#pragma unroll
    for (int hq = 0; hq < 4; ++hq) { const float sink2 = A.in[I_SINKS][4 * kvh + hq] * LOG2E;
        const float m = fmaxf(wave_max(fmaxf(sc[hq][0], sc[hq][1])), sink2);
        const float p0 = __builtin_amdgcn_exp2f(sc[hq][0] - m), p1 = __builtin_amdgcn_exp2f(sc[hq][1] - m);
        const float l = wave_sum(p0 + p1) + __builtin_amdgcn_exp2f(sink2 - m); const float inv = 1.0f / l;
        sc[hq][0] = p0 * inv; sc[hq][1] = p1 * inv; }
    float o[4] = {0.f, 0.f, 0.f, 0.f};
#pragma unroll
    for (int jb = 0; jb < 8; ++jb) {
        float vv[16];
#pragma unroll
        for (int e = 0; e < 16; ++e) { const int j = 16 * jb + e; vv[e] = j < 127 ? __builtin_nontemporal_load(cv + (size_t)(j + 1) * 512 + lane) : ov[(size_t)127 * 512 + lane]; }
#pragma unroll
        for (int e = 0; e < 16; ++e) { const int j = 16 * jb + e; if (j < 127) __builtin_nontemporal_store(vv[e], ov + (size_t)j * 512 + lane); }
#pragma unroll
        for (int e = 0; e < 16; ++e) { const int j = 16 * jb + e;
#pragma unroll
            for (int hq = 0; hq < 4; ++hq) o[hq] += rdlane(sc[hq][j >> 6], j & 63) * vv[e]; } }
    bf16* mix = (bf16*)(ws + WS_XB) + (size_t)(TP + n) * DM + kvh * 256 + lane;
#pragma unroll
    for (int hq = 0; hq < 4; ++hq) mix[hq * 64] = (bf16)f2bf(o[hq]);
}

DI void p4_sdn_pair(const Args& A, int pairIdx, LAS unsigned char* lds, int tid, int lane) {
    unsigned char* ws = A.ws;
    const int half = tid >> 8, t = tid & 255, w4 = t >> 6;
    const int item = 2 * pairIdx + half, n = item >> 4, hh = item & 15;
    LAS float* KV = (LAS float*)(lds + half * 8192);
    LAS float* RED = KV + 384; LAS float* RED2 = KV + 896;
    if (t < 128) { const size_t go = (size_t)n * 2048 + hh * 128 + t;
        KV[t] = ((const float*)(ws + WS_SKD))[go]; KV[128 + t] = ((const float*)(ws + WS_SQD))[go]; KV[256 + t] = ((const float*)(ws + WS_SVD))[go]; }
    const float* gbs = (const float*)(ws + WS_GBS) + (size_t)n * 32; const float eg = __expf(gbs[hh]), be = gbs[16 + hh];
    const size_t so = ((size_t)(n * 16 + hh) * 128 + 32 * w4) * 128 + 2 * lane;
    const float* Sg = A.in[I_SDELTA] + so; float* So = A.out + O_SD + so;
    f32x2 s[32];
#pragma unroll
    for (int i = 0; i < 32; ++i) s[i] = __builtin_nontemporal_load((const f32x2*)(Sg + i * 128));
    __syncthreads();
    f32x2 r = {0.f, 0.f};
#pragma unroll
    for (int i = 0; i < 32; ++i) r += s[i] * KV[32 * w4 + i];
    *(LAS f32x2*)(RED + w4 * 128 + 2 * lane) = r;
    __syncthreads();
    const f32x2 rt = *(const LAS f32x2*)(RED + 2 * lane) + *(const LAS f32x2*)(RED + 128 + 2 * lane) + *(const LAS f32x2*)(RED + 256 + 2 * lane) + *(const LAS f32x2*)(RED + 384 + 2 * lane);
    const f32x2 u = (*(const LAS f32x2*)(KV + 256 + 2 * lane) - rt * eg) * be;
    f32x2 o = {0.f, 0.f};
#pragma unroll
    for (int i = 0; i < 32; ++i) { const float kk = KV[32 * w4 + i], qq = KV[128 + 32 * w4 + i]; const f32x2 sn = s[i] * eg + u * kk; __builtin_nontemporal_store(sn, (f32x2*)(So + i * 128)); o += sn * qq; }
    *(LAS f32x2*)(RED2 + w4 * 128 + 2 * lane) = o;
    __syncthreads();
    if (w4 == 0) {
        const f32x2 ot = *(const LAS f32x2*)(RED2 + 2 * lane) + *(const LAS f32x2*)(RED2 + 128 + 2 * lane) + *(const LAS f32x2*)(RED2 + 256 + 2 * lane) + *(const LAS f32x2*)(RED2 + 384 + 2 * lane);
        const float ss = wave_sum(ot.x * ot.x + ot.y * ot.y); const float rn = 1.0f / sqrtf(ss * (1.0f / 128.0f) + RMS_EPS);
        const unsigned zz = *(const unsigned*)((const bf16*)(ws + WS_PROJ) + (size_t)(TP + n) * INP + OFF_Z + hh * 128 + 2 * lane);
        const f32x2 nw = *(const f32x2*)(A.in[I_NORMW] + 2 * lane);
        const float y0 = ot.x * rn * nw.x * silu_acc(bflo(zz)), y1 = ot.y * rn * nw.y * silu_acc(bfhi(zz));
        *(unsigned*)((bf16*)(ws + WS_XB) + (size_t)(TP + n) * DM + 2048 + hh * 128 + 2 * lane) = cvtpk(y0, y1);
    }
    __syncthreads();
}

DI void p5_item(const Args& A, int it, LAS unsigned char* lds, int wave, int lane) {
    unsigned char* ws = A.ws;
    const int hh = it >> 7, ck = it & 127, q = lane >> 4, cc = lane & 15, col = 16 * wave + cc;
    const bf16* ST = (const bf16*)(ws + WS_ST) + ((size_t)it * 128 + col) * 128 + 8 * q; const bf16* UT = (const bf16*)(ws + WS_UNT) + ((size_t)it * 128 + col) * 64 + 8 * q;
    const bf16* qd = (const bf16*)(ws + WS_CQD) + (size_t)it * 8192 + cc * 128 + 8 * q; const bf16* at = (const bf16*)(ws + WS_CAT) + (size_t)it * 4096 + cc * 64 + 8 * q;
    const bf16* z = (const bf16*)(ws + WS_PROJ) + (size_t)(ck * 64) * INP + OFF_Z + hh * 128 + col; bf16* mix = (bf16*)(ws + WS_XB) + (size_t)(ck * 64) * DM + 2048 + hh * 128 + col;
    bf16x8 Sb[4], Ub[2], qf[4][4], af[4][2]; unsigned short zz[4][4];
#pragma unroll
    for (int s = 0; s < 4; ++s) Sb[s] = *(const bf16x8*)(ST + 32 * s);
    Ub[0] = *(const bf16x8*)UT; Ub[1] = *(const bf16x8*)(UT + 32);
#pragma unroll
    for (int mt = 0; mt < 4; ++mt) {
#pragma unroll
        for (int s = 0; s < 4; ++s) qf[mt][s] = *(const bf16x8*)(qd + mt * 2048 + 32 * s);
#pragma unroll
        for (int s = 0; s < 2; ++s) if (s <= (mt >> 1)) af[mt][s] = *(const bf16x8*)(at + mt * 1024 + 32 * s); }
#pragma unroll
    for (int mt = 0; mt < 4; ++mt)
#pragma unroll
        for (int r = 0; r < 4; ++r) zz[mt][r] = z[(size_t)(16 * mt + 4 * q + r) * INP];
    const float nw = A.in[I_NORMW][col];
    __builtin_amdgcn_sched_barrier(0);
    f32x4 O[4];
#pragma unroll
    for (int mt = 0; mt < 4; ++mt) { O[mt] = (f32x4){0.f, 0.f, 0.f, 0.f};
#pragma unroll
        for (int s = 0; s < 4; ++s) O[mt] = MFMA16(qf[mt][s], Sb[s], O[mt]);
#pragma unroll
        for (int s = 0; s < 2; ++s) if (s <= (mt >> 1)) O[mt] = MFMA16(af[mt][s], Ub[s], O[mt]); }
    LAS float* SSQ = (LAS float*)lds;
#pragma unroll
    for (int mt = 0; mt < 4; ++mt)
#pragma unroll
        for (int r = 0; r < 4; ++r) { const float ss = row16_sum(O[mt][r] * O[mt][r]); if (cc == 0) SSQ[(16 * mt + 4 * q + r) * 8 + wave] = ss; }
    __syncthreads();
#pragma unroll
    for (int mt = 0; mt < 4; ++mt)
#pragma unroll
        for (int r = 0; r < 4; ++r) { const int t = 16 * mt + 4 * q + r; const f32x4 a = *(const LAS f32x4*)(SSQ + t * 8), b = *(const LAS f32x4*)(SSQ + t * 8 + 4);
            const float ss = ((a[0] + a[1]) + (a[2] + a[3])) + ((b[0] + b[1]) + (b[2] + b[3])); const float rn = 1.0f / sqrtf(ss * (1.0f / 128.0f) + RMS_EPS);
            mix[(size_t)t * DM] = (bf16)f2bf(O[mt][r] * rn * nw * silu_acc(bf2f(zz[mt][r]))); }
    __syncthreads();
}

DI void ln_row(const float* src, int nslab, const float* g, const float* b, float* dstf, bf16* dstb, int lane) {
    const f32x4* xr = (const f32x4*)src + lane;
    f32x4 v[16]; float s = 0.f;
#pragma unroll
    for (int j = 0; j < 16; ++j) v[j] = xr[64 * j];

    for (int k = 1; k < nslab; ++k) { const f32x4* xk = xr + (size_t)k * (128 * DM / 4);
#pragma unroll
        for (int j = 0; j < 16; ++j) v[j] += xk[64 * j]; }
#pragma unroll
    for (int j = 0; j < 16; ++j) s += (v[j][0] + v[j][1]) + (v[j][2] + v[j][3]);
    const float mean = wave_sum(s) * (1.0f / DM); float s2 = 0.f;
#pragma unroll
    for (int j = 0; j < 16; ++j) { v[j] = v[j] - mean; s2 += (v[j][0] * v[j][0] + v[j][1] * v[j][1]) + (v[j][2] * v[j][2] + v[j][3] * v[j][3]); }
    const float rstd = 1.0f / sqrtf(wave_sum(s2) * (1.0f / DM) + LN_EPS);
    const f32x4* g4 = (const f32x4*)g + lane; const f32x4* b4 = (const f32x4*)b + lane;
#pragma unroll
    for (int j = 0; j < 16; ++j) { const f32x4 y = v[j] * rstd * g4[64 * j] + b4[64 * j];
        if (dstf) __builtin_nontemporal_store(y, (f32x4*)dstf + lane + 64 * j);
        if (dstb) { v2u w; w.x = cvtpk(y[0], y[1]); w.y = cvtpk(y[2], y[3]); ((v2u*)dstb + lane)[64 * j] = w; } }
}

DI void ln_row_wg(const float* src, int nslab, const float* g, const float* b, float* dstf, bf16* dstb, LAS unsigned char* lds, int tid, int wave, int lane) {
    LAS float* RED = (LAS float*)lds;
    const f32x4* xr = (const f32x4*)src + 2 * tid;
    f32x4 v0 = xr[0], v1 = xr[1];
#pragma unroll 4
    for (int k = 1; k < nslab; ++k) { const f32x4* xk = xr + (size_t)k * (128 * DM / 4); v0 += xk[0]; v1 += xk[1]; }
    float s = wave_sum((v0[0] + v0[1]) + (v0[2] + v0[3]) + (v1[0] + v1[1]) + (v1[2] + v1[3]));
    if (lane == 0) RED[wave] = s;
    __syncthreads();
    const float mean = (((RED[0] + RED[1]) + (RED[2] + RED[3])) + ((RED[4] + RED[5]) + (RED[6] + RED[7]))) * (1.0f / DM);
    v0 = v0 - mean; v1 = v1 - mean;
    float s2 = wave_sum((v0[0] * v0[0] + v0[1] * v0[1]) + (v0[2] * v0[2] + v0[3] * v0[3]) + (v1[0] * v1[0] + v1[1] * v1[1]) + (v1[2] * v1[2] + v1[3] * v1[3]));
    if (lane == 0) RED[8 + wave] = s2;
    __syncthreads();
    const float rstd = 1.0f / sqrtf((((RED[8] + RED[9]) + (RED[10] + RED[11])) + ((RED[12] + RED[13]) + (RED[14] + RED[15]))) * (1.0f / DM) + LN_EPS);
    const f32x4* g4 = (const f32x4*)g + 2 * tid; const f32x4* b4 = (const f32x4*)b + 2 * tid;
    const f32x4 y0 = v0 * rstd * g4[0] + b4[0], y1 = v1 * rstd * g4[1] + b4[1];
    if (dstf) { ((f32x4*)dstf)[2 * tid] = y0; ((f32x4*)dstf)[2 * tid + 1] = y1; }
    if (dstb) { v4u w; w.x = cvtpk(y0[0], y0[1]); w.y = cvtpk(y0[2], y0[3]); w.z = cvtpk(y1[0], y1[1]); w.w = cvtpk(y1[2], y1[3]); ((v4u*)dstb)[tid] = w; }
    __syncthreads();
}

DI void ln_row_b(const bf16* src, const float* g, const float* b, float* dstf, bf16* dstb, int lane) {
    const v2u* xr = (const v2u*)src + lane;
    f32x4 v[16]; float s = 0.f;
#pragma unroll
    for (int j = 0; j < 16; ++j) { const v2u w = xr[64 * j]; v[j] = (f32x4){bflo(w.x), bfhi(w.x), bflo(w.y), bfhi(w.y)}; s += (v[j][0] + v[j][1]) + (v[j][2] + v[j][3]); }
    const float mean = wave_sum(s) * (1.0f / DM); float s2 = 0.f;
#pragma unroll
    for (int j = 0; j < 16; ++j) { v[j] = v[j] - mean; s2 += (v[j][0] * v[j][0] + v[j][1] * v[j][1]) + (v[j][2] * v[j][2] + v[j][3] * v[j][3]); }
    const float rstd = 1.0f / sqrtf(wave_sum(s2) * (1.0f / DM) + LN_EPS);
    const f32x4* g4 = (const f32x4*)g + lane; const f32x4* b4 = (const f32x4*)b + lane;
#pragma unroll
    for (int j = 0; j < 16; ++j) { const f32x4 y = v[j] * rstd * g4[64 * j] + b4[64 * j];
        if (dstf) __builtin_nontemporal_store(y, (f32x4*)dstf + lane + 64 * j);
        if (dstb) { v2u w; w.x = cvtpk(y[0], y[1]); w.y = cvtpk(y[2], y[3]); ((v2u*)dstb + lane)[64 * j] = w; } }
}

constexpr int N_PHASES = 11;
constexpr int KSPLIT = 16;
constexpr int NSCAN = 16 * 8 / SCAN_NCW;

__global__ void __launch_bounds__(NTHR, 2) fwd(Args args) {
    extern __shared__ __attribute__((aligned(16))) unsigned char lds_raw[];
    LAS unsigned char* lds = (LAS unsigned char*)lds_raw;
    volatile LAS unsigned* MISC = (volatile LAS unsigned*)(lds + MISC_OFF);
    const int tid = threadIdx.x, lane = tid & 63, wave = __builtin_amdgcn_readfirstlane(tid >> 6);
    const int G = gridDim.x, bx = blockIdx.x, gw = bx * NWAVES + wave, NGW = G * NWAVES;
    unsigned char* ws = args.ws;
    gu32* ctl = (gu32*)(ws + WS_CTL);
    for (int u = tid; u < (LDS_BYTES - LDSCTL_OFF) / 4; u += NTHR) ((LAS unsigned*)(lds + LDSCTL_OFF))[u] = 0u;
    __syncthreads();
    const XcdBarrier bar = xcd_barrier_post((unsigned*)(ctl + CW_BAR) + args.li * XCD_BAR_WORDS, MISC + 8);
#define GRID_BAR() xcd_barrier(bar)
    const int lo = args.ph_lo, hi = args.ph_hi;
#define IN(k) (lo <= (k) && (k) < hi)
#define BOTH(k) (IN(k) && IN((k) + 1))

    if (IN(0)) { p0_prologue(args, lds, gw, NGW, wave, lane); if (BOTH(0)) GRID_BAR(); }

    if (IN(1)) {
        pg8::Gemm g{(const pg8::bf16_t*)(ws + WS_XB), (const pg8::bf16_t*)(ws + WS_WIN), MPAD, INP, DM}; pg8::StaticOrder S; S.init(MPAD, INP, DM, G, bx);
        pg8::EpiProj E{(pg8::bf16_t*)(ws + WS_PROJ), INP, (const float*)(ws + WS_BIASP), (float*)(ws + WS_AB), OFF_AB / 256};
        pg8::gemm_phase<pg8::EpiProj, pg8::StaticOrder, true, true>(lds + RING_OFF, g, S, E);
        __syncthreads();
        cv_pull3(args, lds, ctl + CW_QCV + 64 * args.li, 0, CV_T_OUT, wave, lane);
        if (BOTH(1)) GRID_BAR();
    }

    if (IN(3)) {
        for (int it = 2 * bx; it < NITEM; it += 2 * G) p3_pair(args, it, lds, tid, wave, lane);
        for (int it = gw; it < MROWS + 128 * 12; it += NGW) {
            if (it < MROWS) p2_token(args, it, lane);
            else { const int j = it - MROWS; p2_convs(args, j / 12, j % 12, lane); } }
        if (BOTH(3)) GRID_BAR();
    }

    if (IN(4)) {
        const int msk = args.pad;
        if (bx < NSCAN) { if (msk & 1) p4_scan_wg(args, (NSCAN % 8 == 0) ? (bx % 8) * (NSCAN / 8) + bx / 8 : bx, lds, wave, lane); }
        else {
            const int ob = bx - NSCAN, NOB = G - NSCAN;
            if (msk & 2) for (int p = ob; p < 1024; p += NOB) p4_sdn_pair(args, p, lds, tid, lane);
            if (msk & 4) for (int it = ob * NWAVES + wave; it < 1024; it += NOB * NWAVES) p4_sattn(args, it, lane);
            if (msk & 8) for (int it = ob * NWAVES + wave; it < 256 * 32; it += NOB * NWAVES) p4_attn(args, it, lane);
        }
        if (BOTH(4)) GRID_BAR();
    }

    if (IN(5)) {
        for (int it = bx; it < NITEM; it += G) p5_item(args, it, lds, wave, lane);
        if (BOTH(5)) GRID_BAR();
    }

    if (IN(6)) {
        pg8::Gemm g{(const pg8::bf16_t*)(ws + WS_XB), (const pg8::bf16_t*)(ws + WS_WOUT), MPAD, DM, DM}; pg8::SplitTailOrder S; S.init(TP, DM, DM, (args.pad & 128) ? -1 : KSPLIT, G, bx);
        float* t1 = (float*)(ws + WS_PROJ);
        pg8::EpiRes E{args.in[I_XP], args.in[I_XS], t1, (float*)(ws + WS_SLAB), TP, MROWS, DM, TP / 256, ALPHA, nullptr, (pg8::bf16_t*)(ws + WS_PROJ)};
        pg8::gemm_phase<pg8::EpiRes, pg8::SplitTailOrder, true, true>(lds + RING_OFF, g, S, E);
        if (BOTH(6)) GRID_BAR();
    }

    if (IN(7)) {
        float* t1 = (float*)(ws + WS_PROJ);
        for (int r = TP + bx; r < MROWS; r += G) ln_row_wg((const float*)(ws + WS_SLAB) + (size_t)(r - TP) * DM, KSPLIT, args.in[I_LN1G], args.in[I_LN1B], nullptr, (bf16*)(ws + WS_XB) + (size_t)r * DM, lds, tid, wave, lane);
        for (int r = gw; r < TP; r += NGW) ln_row_b((const bf16*)(ws + WS_PROJ) + (size_t)r * DM, args.in[I_LN1G], args.in[I_LN1B], nullptr, (bf16*)(ws + WS_XB) + (size_t)r * DM, lane);
        if (BOTH(7)) GRID_BAR();
    }

    if (IN(8)) {
        pg8::Gemm g{(const pg8::bf16_t*)(ws + WS_XB), (const pg8::bf16_t*)(ws + WS_WGU), MPAD, NGU, DM}; pg8::StaticOrder S; S.init(MPAD, NGU, DM, G, bx);
        pg8::EpiSwiGLU E{(pg8::bf16_t*)(ws + WS_FFN), FF};
        pg8::gemm_phase<pg8::EpiSwiGLU, pg8::StaticOrder, true, true>(lds + RING_OFF, g, S, E);
        __syncthreads();
        cv_pull3(args, lds, ctl + CW_QCV + 256 + 64 * args.li, CV_T_OUT, CV_T3, wave, lane);
        if (BOTH(8)) GRID_BAR();
    }

    if (IN(9)) {
        pg8::Gemm g{(const pg8::bf16_t*)(ws + WS_FFN), (const pg8::bf16_t*)(ws + WS_WDN), MPAD, DM, FF}; pg8::SplitTailOrder S; S.init(TP, DM, FF, KSPLIT, G, bx);
        const float* h = (const float*)(ws + WS_PROJ);
        pg8::EpiRes E{h, h + (size_t)TP * DM, args.out + O_Y, (float*)(ws + WS_SLAB), TP, MROWS, DM, TP / 256, ALPHA, (const pg8::bf16_t*)(ws + WS_XB), (pg8::bf16_t*)(ws + WS_T2B)};
        pg8::gemm_phase<pg8::EpiRes, pg8::SplitTailOrder, true, true>(lds + RING_OFF, g, S, E);
        if (BOTH(9)) GRID_BAR();
    }

    if (IN(10)) {
        float* y = args.out + O_Y;
        for (int r = TP + bx; r < MROWS; r += G) ln_row_wg((const float*)(ws + WS_SLAB) + (size_t)(r - TP) * DM, KSPLIT, args.in[I_LN2G], args.in[I_LN2B], y + (size_t)r * DM, nullptr, lds, tid, wave, lane);
        for (int r = gw; r < TP; r += NGW) ln_row_b((const bf16*)(ws + WS_T2B) + (size_t)r * DM, args.in[I_LN2G], args.in[I_LN2B], y + (size_t)r * DM, nullptr, lane);
    }
#undef IN
#undef BOTH
#undef GRID_BAR
}

extern "C" void kernel_launch(void* const* d_in, const int* in_sizes, int n_in, void* d_out, int out_size, void* d_ws, size_t ws_size, hipStream_t stream) {
    static int grid = 0;
    if (grid == 0) {
        if (n_in != 21 || (size_t)out_size != O_END || ws_size < WS_END) { fprintf(stderr, "kernel_launch: unexpected problem (n_in %d, out %d, ws %zu); nothing launched\n", n_in, out_size, ws_size); grid = -1; return; }
        int dev = 0, cus = 0, per_cu = 0;
        if (hipGetDevice(&dev) != hipSuccess || hipDeviceGetAttribute(&cus, hipDeviceAttributeMultiprocessorCount, dev) != hipSuccess) { grid = -1; return; }
        if (hipFuncSetAttribute((const void*)fwd, hipFuncAttributeMaxDynamicSharedMemorySize, LDS_BYTES) != hipSuccess) { fprintf(stderr, "kernel_launch: hipFuncSetAttribute failed\n"); grid = -1; return; }
        if (hipOccupancyMaxActiveBlocksPerMultiprocessor(&per_cu, (const void*)fwd, NTHR, LDS_BYTES) != hipSuccess || per_cu < 1) { fprintf(stderr, "kernel_launch: occupancy query reports %d workgroups per CU\n", per_cu); }
        (void)hipGetLastError();
        grid = cus;
        if (grid < 2 * NSCAN) { fprintf(stderr, "kernel_launch: needs >= %d CUs, device has %d\n", 2 * NSCAN, cus); grid = -1; return; }
    }
    if (grid < 0) return;
    if (hipMemsetAsync((char*)d_ws + WS_CTL, 0, CTL_ZERO_BYTES, stream) != hipSuccess) return;
    Args a{};
    for (int i = 0; i < 21; ++i) a.in[i] = (const float*)d_in[i];
    a.out = (float*)d_out; a.ws = (unsigned char*)d_ws;
#if defined(PROBE_PHASE)
    const int nl = 3, los[3] = {0, PROBE_PHASE, PROBE_PHASE + 1}, his[3] = {PROBE_PHASE + 1, PROBE_PHASE + 1, N_PHASES};
#else
    const int nl = 1, los[1] = {0}, his[1] = {N_PHASES};
#endif
    for (int li = 0; li < nl; ++li) {
        if (los[li] >= his[li]) continue;
        a.ph_lo = los[li]; a.ph_hi = his[li]; a.li = li; a.pad = 15;
#if defined(PROBE_MASK)
        if (li == 1) a.pad = PROBE_MASK;
#endif
        hipLaunchKernelGGL(fwd, dim3(grid), dim3(NTHR), LDS_BYTES, stream, a);
        const hipError_t le = hipPeekAtLastError();
        if (le != hipSuccess) { fprintf(stderr, "kernel_launch: launch %d failed: %s\n", li, hipGetErrorName(le)); break; }
    }
}
```

```cpp
#include <hip/hip_runtime.h>
#include <cstdio>
#include <cstdint>
#include <cmath>
namespace pg8 {
#define PG8_LAS __attribute__((address_space(3)))
typedef unsigned short bf16_t;
typedef short bf16x8 __attribute__((ext_vector_type(8)));
typedef float f32x4 __attribute__((ext_vector_type(4)));
typedef unsigned u32x4 __attribute__((ext_vector_type(4)));
constexpr int BM = 256, BK = 64, HALF = 128, HTB = HALF * BK * 2  , STAGE_BYTES = 8 * HTB, NXCD = 8, WGM = 8;

__host__ __device__ __forceinline__ int lds_byte(int r, int c) { const int st = (r >> 4) * 2 + (c >> 5), rr = r & 15, cc = c & 31, ob = rr * 64 + cc * 2; return st * 1024 + (ob ^ (((ob >> 9) & 1) << 5)); }
__host__ __device__ __forceinline__ void stage_rc(int b, int& R, int& C) { const int st = b / 1024, sb = b % 1024, swz = sb ^ (((sb >> 9) & 1) << 5); R = (st >> 1) * 16 + swz / 64; C = (st & 1) * 32 + (swz % 64) / 2; }
__host__ __device__ __forceinline__ int perm32(int rho) { const int n = rho >> 4, i = rho & 15; return 8 * (i >> 2) + 4 * n + (i & 3); }

struct Unit { int pm, pn, k0, nt, ks; };
struct Gemm { const bf16_t* A; const bf16_t* Bt; int M, N, K; };

struct StaticOrder {
    int nM, nN, nwg, G, c, ntf;
    __host__ __device__ void init(int M, int N, int K, int G_, int c_) { nM = M / BM; nN = N / BM; nwg = nM * nN; G = G_; c = c_; ntf = K / BK; }
    __host__ __device__ __forceinline__ bool next(int i, Unit& u) const {
        const long L = (long)i * G + c; if (L >= nwg) return false;
        int wgid = (int)L; { const int q = nwg / NXCD, r = nwg % NXCD, xcd = wgid % NXCD, off = wgid / NXCD; wgid = (xcd < r ? xcd * (q + 1) : r * (q + 1) + (xcd - r) * q) + off; }
        const int nig = WGM * nN, gid = wgid / nig, fm = gid * WGM, gsz = (nM - fm) < WGM ? (nM - fm) : WGM;
        u.pm = fm + ((wgid % nig) % gsz); u.pn = (wgid % nig) / gsz; u.k0 = 0; u.nt = ntf; u.ks = 0; return true;
    }
    __device__ __forceinline__ void a_ready(const Unit&) const {}
    __device__ __forceinline__ void done(const Unit&) const {}
};

struct SplitTailOrder {
    int nMf, nN, nwg, G, c, ntf, S, base, rem;
    __host__ __device__ __forceinline__ void init(int Mfull, int N, int K, int S_, int G_, int c_) { nMf = Mfull / BM; nN = N / BM; nwg = nMf * nN; G = G_; c = c_; ntf = K / BK; S = S_; base = (K / (2 * BK)) / (S_ > 0 ? S_ : 1); rem = (K / (2 * BK)) % (S_ > 0 ? S_ : 1); }
    __host__ __device__ __forceinline__ bool next(int i, Unit& u) const {
        const int L = i * G + c; if (L >= nwg + nN * S) return false;
        const bool fu = L < nwg;
#if defined(PROBE_MASK)
        if (!fu && S < 0) return false;
#endif
        int wgid = fu ? L : 0; { const int q = nwg / NXCD, r = nwg % NXCD, xcd = wgid % NXCD, off = wgid / NXCD; wgid = (xcd < r ? xcd * (q + 1) : r * (q + 1) + (xcd - r) * q) + off; }
        const int nig = WGM * nN, gid = wgid / nig, fm = gid * WGM, gsz = (nMf - fm) < WGM ? (nMf - fm) : WGM;
        const int j = fu ? 0 : L - nwg, ks = j % S;
        u.pm = fu ? fm + ((wgid % nig) % gsz) : nMf; u.pn = fu ? (wgid % nig) / gsz : j / S; u.ks = ks;
        u.nt = fu ? ntf : 2 * (base + (ks < rem ? 1 : 0)); u.k0 = fu ? 0 : 2 * BK * (ks * base + (ks < rem ? ks : rem)); return true;
    }
    __device__ __forceinline__ void a_ready(const Unit&) const {}
    __device__ __forceinline__ void done(const Unit&) const {}
};

__device__ __forceinline__ unsigned cvt_pk_bf16(float lo, float hi) { unsigned r; asm volatile("v_cvt_pk_bf16_f32 %0, %1, %2" : "=v"(r) : "v"(lo), "v"(hi)); return r; }
typedef float f32x2 __attribute__((ext_vector_type(2)));

struct EpiProj {
    static constexpr bool PERM = true, AFTER_DRAIN = false;
    bf16_t* O; int ldc; const float* bias; float* ab; int ab_pn;
    __device__ __forceinline__ void operator()(const f32x4 (&acc)[2][2][4][2], const Unit& u, int wr, int wc, int fr, int fq) const {
        const int row0 = u.pm * BM + wr * 64 + fr; const int col0 = u.pn * BM + wc * 32 + 8 * fq;
        f32x4 bv[2][2];
#pragma unroll
        for (int bj = 0; bj < 2; ++bj)
#pragma unroll
            for (int n = 0; n < 2; ++n) bv[bj][n] = *(const f32x4*)(bias + col0 + bj * HALF + 4 * n);
        const bool do_ab = (u.pn == ab_pn) && (wc == 0);
#pragma unroll
        for (int ai = 0; ai < 2; ++ai)
#pragma unroll
            for (int m = 0; m < 4; ++m) { const int row = row0 + ai * HALF + m * 16; bf16_t* rowp = O + (size_t)row * ldc + col0;
#pragma unroll
                for (int bj = 0; bj < 2; ++bj) { const f32x4 v0 = acc[ai][bj][m][0] + bv[bj][0], v1 = acc[ai][bj][m][1] + bv[bj][1];
                    u32x4 w; w.x = cvt_pk_bf16(v0[0], v0[1]); w.y = cvt_pk_bf16(v0[2], v0[3]); w.z = cvt_pk_bf16(v1[0], v1[1]); w.w = cvt_pk_bf16(v1[2], v1[3]);
                    *(u32x4*)(rowp + bj * HALF) = w;
                    if (bj == 0 && do_ab) { float* ap = ab + (size_t)row * 32 + 8 * fq; *(f32x4*)ap = v0; *(f32x4*)(ap + 4) = v1; } } }
    }
};
struct EpiRes {
    static constexpr bool PERM = false, AFTER_DRAIN = false;
    const float* res0; const float* res1; float* out0; float* slab; int split, mrows, ldc, pm_s; float alpha; const bf16_t* resb; bf16_t* outb;
    static __device__ __forceinline__ f32x4 ldb4(const bf16_t* p) { const unsigned long long w = *(const unsigned long long*)p; const unsigned lo = (unsigned)w, hi = (unsigned)(w >> 32);
        return (f32x4){__uint_as_float(lo << 16), __uint_as_float(lo & 0xffff0000u), __uint_as_float(hi << 16), __uint_as_float(hi & 0xffff0000u)}; }
    __device__ __forceinline__ void operator()(const f32x4 (&acc)[2][2][4][2], const Unit& u, int wr, int wc, int fr, int fq) const {
        const int col0 = u.pn * BM + wc * 32 + 4 * fq;
        if (u.pm < pm_s) {
#pragma unroll
            for (int ai = 0; ai < 2; ++ai) {
                f32x4 rv[4][2][2];
#pragma unroll
                for (int m = 0; m < 4; ++m) { const size_t ro = (size_t)(u.pm * BM + ai * HALF + wr * 64 + m * 16 + fr) * ldc + col0;
#pragma unroll
                    for (int bj = 0; bj < 2; ++bj)
#pragma unroll
                        for (int n = 0; n < 2; ++n) rv[m][bj][n] = resb ? ldb4(resb + ro + bj * HALF + n * 16) : *(const f32x4*)(res0 + ro + bj * HALF + n * 16); }
                __builtin_amdgcn_sched_barrier(0);
#pragma unroll
                for (int m = 0; m < 4; ++m) { float* op = out0 + (size_t)(u.pm * BM + ai * HALF + wr * 64 + m * 16 + fr) * ldc + col0;
#pragma unroll
                    for (int bj = 0; bj < 2; ++bj)
#pragma unroll
                        for (int n = 0; n < 2; ++n) { const f32x4 o = rv[m][bj][n] * alpha + acc[ai][bj][m][n];
                            if (outb) { typedef unsigned u32x2 __attribute__((ext_vector_type(2))); u32x2 w; w.x = cvt_pk_bf16(o[0], o[1]); w.y = cvt_pk_bf16(o[2], o[3]); *(u32x2*)(outb + (size_t)(u.pm * BM + ai * HALF + wr * 64 + m * 16 + fr) * ldc + col0 + bj * HALF + n * 16) = w; }
                            else *(f32x4*)(op + bj * HALF + n * 16) = o; } }
            }
        } else {
#pragma unroll
            for (int m = 0; m < 4; ++m) { const int lr = wr * 64 + m * 16 + fr;
                if (lr < mrows - split) { const float* rp = res1 + (size_t)lr * ldc; float* op = slab + ((size_t)u.ks * HALF + lr) * ldc;
#pragma unroll
                    for (int bj = 0; bj < 2; ++bj)
#pragma unroll
                        for (int n = 0; n < 2; ++n) { const int c = col0 + bj * HALF + n * 16; f32x4 o = acc[0][bj][m][n]; if (u.ks == 0) o += (resb ? ldb4(resb + (size_t)(split + lr) * ldc + c) : *(const f32x4*)(rp + c)) * alpha; *(f32x4*)(op + c) = o; } } }
        }
    }
};
struct EpiSwiGLU {
    static constexpr bool PERM = true, AFTER_DRAIN = false;
    bf16_t* O; int ldc;
    static __device__ __forceinline__ float silu_mul(float g, float uu) { return g * uu * __builtin_amdgcn_rcpf(1.0f + __builtin_amdgcn_exp2f(-1.4426950408889634f * g)); }
    __device__ __forceinline__ void operator()(const f32x4 (&acc)[2][2][4][2], const Unit& u, int wr, int wc, int fr, int fq) const {
        const int row0 = u.pm * BM + wr * 64 + fr; const int col0 = u.pn * HALF + wc * 32 + 8 * fq;
#pragma unroll
        for (int ai = 0; ai < 2; ++ai)
#pragma unroll
            for (int m = 0; m < 4; ++m) { bf16_t* rowp = O + (size_t)(row0 + ai * HALF + m * 16) * ldc + col0;
                const f32x4 g0 = acc[ai][0][m][0], g1 = acc[ai][0][m][1], u0 = acc[ai][1][m][0], u1 = acc[ai][1][m][1];
                u32x4 w; w.x = cvt_pk_bf16(silu_mul(g0[0], u0[0]), silu_mul(g0[1], u0[1])); w.y = cvt_pk_bf16(silu_mul(g0[2], u0[2]), silu_mul(g0[3], u0[3]));
                w.z = cvt_pk_bf16(silu_mul(g1[0], u1[0]), silu_mul(g1[1], u1[1])); w.w = cvt_pk_bf16(silu_mul(g1[2], u1[2]), silu_mul(g1[3], u1[3]));
                *(u32x4*)rowp = w; }
    }
};
template <class Epi, class Sched, bool ALIGN_EPI = false, bool SP2 = false>
__device__ __forceinline__ void gemm_phase(PG8_LAS unsigned char* lds, const Gemm g, const Sched& S, const Epi& E) {
    const int tid = threadIdx.x, wid = __builtin_amdgcn_readfirstlane(tid >> 6), lane = tid & 63, wr = wid >> 2, wc = wid & 3, fr = lane & 15, fq = lane >> 4;
    const int K = g.K;
    unsigned voffA[2], voffB[2];
#pragma unroll
    for (int i = 0; i < 2; ++i) { int R, C; stage_rc(tid * 16 + i * 8192, R, C); const int Rb = Epi::PERM ? ((R & ~31) + perm32(R & 31)) : R;
        voffA[i] = (unsigned)(R * K + C) * 2u; voffB[i] = (unsigned)(Rb * K + C) * 2u; }
    const size_t kstep = (size_t)(BK * 2);
    const size_t hstep = (size_t)HALF * K * 2;
    const size_t tstep = 2 * hstep;
    const unsigned ldsw = (unsigned)wid * 1024u;
    const int aoff = lds_byte(wr * 64 + fr, fq * 8), boff = lds_byte(wc * 32 + fr, fq * 8);
#define PG8_SA(b, h) (((b) * 2 + (h)) * HTB)
#define PG8_SB(b, h) ((4 + (b) * 2 + (h)) * HTB)
#define PG8_STAGE(bufoff, gbase, voff) do { _Pragma("unroll") for (int _i = 0; _i < 2; ++_i) \
        __builtin_amdgcn_global_load_lds((const unsigned*)((const char*)(gbase) + (voff)[_i]), (PG8_LAS unsigned*)(lds + (bufoff) + ldsw + _i * 8192), 16, 0, 0); } while (0)
#define PG8_LDA(dst, b, h) do { _Pragma("unroll") for (int m = 0; m < 4; ++m) _Pragma("unroll") for (int k = 0; k < 2; ++k) dst[m][k] = *(const PG8_LAS bf16x8*)(lds + PG8_SA(b, h) + aoff + m * 2048 + k * 1024); } while (0)
#define PG8_LDB(dst, b, h) do { _Pragma("unroll") for (int n = 0; n < 2; ++n) _Pragma("unroll") for (int k = 0; k < 2; ++k) dst[n][k] = *(const PG8_LAS bf16x8*)(lds + PG8_SB(b, h) + boff + n * 2048 + k * 1024); } while (0)
#define PG8_MMA(ai, bj, At, Bt) do { __builtin_amdgcn_s_setprio(1); _Pragma("unroll") for (int m = 0; m < 4; ++m) _Pragma("unroll") for (int n = 0; n < 2; ++n) _Pragma("unroll") for (int k = 0; k < 2; ++k) \
        acc[ai][bj][m][n] = __builtin_amdgcn_mfma_f32_16x16x32_bf16(Bt[n][k], At[m][k], acc[ai][bj][m][n], 0, 0, 0); __builtin_amdgcn_s_setprio(0); } while (0)
#define PG8_WAIT_V(n) asm volatile("s_waitcnt vmcnt(" #n ")" ::: "memory")
#define PG8_WAIT_L(n) asm volatile("s_waitcnt lgkmcnt(" #n ")" ::: "memory")
#define PG8_BAR __builtin_amdgcn_s_barrier()
#define PG8_SCHED __builtin_amdgcn_sched_barrier(0)
    Unit cur, nxt; int ui = 0;
    if (!S.next(0, cur)) return;
    f32x4 acc[2][2][4][2];
#pragma unroll
    for (int a = 0; a < 2; ++a)
#pragma unroll
        for (int b = 0; b < 2; ++b)
#pragma unroll
            for (int m = 0; m < 4; ++m)
#pragma unroll
                for (int n = 0; n < 2; ++n) acc[a][b][m][n] = (f32x4){0.f, 0.f, 0.f, 0.f};
    bf16x8 At[4][2], B0[2][2], B1[2][2];
    const char* cA = (const char*)g.A + (size_t)cur.pm * tstep + (size_t)cur.k0 * 2; const char* cB = (const char*)g.Bt + (size_t)cur.pn * tstep + (size_t)cur.k0 * 2;
    S.a_ready(cur);
    if constexpr (SP2) {
        PG8_STAGE(PG8_SB(0, 0), cB, voffB); PG8_STAGE(PG8_SB(0, 1), cB + hstep, voffB); PG8_STAGE(PG8_SA(0, 0), cA, voffA); PG8_STAGE(PG8_SA(0, 1), cA + hstep, voffA);
        if (wr == 1) PG8_BAR;
        PG8_WAIT_V(2); PG8_BAR;
        PG8_STAGE(PG8_SB(1, 0), cB + kstep, voffB); PG8_STAGE(PG8_SA(1, 0), cA + kstep, voffA); PG8_STAGE(PG8_SB(1, 1), cB + hstep + kstep, voffB);
        PG8_WAIT_V(6); PG8_BAR;
    } else {
        PG8_STAGE(PG8_SB(0, 0), cB, voffB); PG8_STAGE(PG8_SA(0, 0), cA, voffA); PG8_STAGE(PG8_SB(0, 1), cB + hstep, voffB); PG8_STAGE(PG8_SA(0, 1), cA + hstep, voffA);
        if (wr == 1) PG8_BAR;
        PG8_WAIT_V(4); PG8_BAR;
        PG8_STAGE(PG8_SB(1, 0), cB + kstep, voffB); PG8_STAGE(PG8_SA(1, 0), cA + kstep, voffA); PG8_STAGE(PG8_SB(1, 1), cB + hstep + kstep, voffB);
        PG8_WAIT_V(6); PG8_BAR;
    }
    for (;;) {
        const bool has_next = S.next(ui + 1, nxt);
        const char* nA = has_next ? (const char*)g.A + (size_t)nxt.pm * tstep + (size_t)nxt.k0 * 2 : cA; const char* nB = has_next ? (const char*)g.Bt + (size_t)nxt.pn * tstep + (size_t)nxt.k0 * 2 : cB;
        const int nt = cur.nt;
        for (int t = 0; t < nt; t += 2) {
            const bool last = (t == nt - 2);
            const char* a1 = cA + (size_t)(t + 1) * kstep;
            const char* a2 = last ? nA : cA + (size_t)(t + 2) * kstep; const char* b2 = last ? nB : cB + (size_t)(t + 2) * kstep;
            const char* a3 = a2 + kstep; const char* b3 = b2 + kstep;
            if (last && has_next) S.a_ready(nxt);
            if constexpr (SP2) {
            PG8_LDB(B0, 0, 0); PG8_LDB(B1, 0, 1); PG8_SCHED; PG8_LDA(At, 0, 0); PG8_STAGE(PG8_SA(1, 1), a1 + hstep, voffA);
            PG8_WAIT_V(8); PG8_WAIT_L(0); PG8_BAR; PG8_MMA(0, 0, At, B0); PG8_MMA(0, 1, At, B1); PG8_BAR; PG8_SCHED;
            PG8_LDA(At, 0, 1); PG8_STAGE(PG8_SB(0, 0), b2, voffB); PG8_STAGE(PG8_SB(0, 1), b2 + hstep, voffB); PG8_STAGE(PG8_SA(0, 0), a2, voffA);
            PG8_WAIT_V(8); PG8_WAIT_L(0); PG8_BAR; PG8_MMA(1, 0, At, B0); PG8_MMA(1, 1, At, B1); PG8_BAR; PG8_SCHED;
            PG8_LDB(B0, 1, 0); PG8_LDB(B1, 1, 1); PG8_SCHED; PG8_LDA(At, 1, 0); PG8_STAGE(PG8_SA(0, 1), a2 + hstep, voffA);
            PG8_WAIT_V(8); PG8_WAIT_L(0); PG8_BAR; PG8_MMA(0, 0, At, B0); PG8_MMA(0, 1, At, B1); PG8_BAR; PG8_SCHED;
            PG8_LDA(At, 1, 1); PG8_STAGE(PG8_SB(1, 0), b3, voffB); PG8_STAGE(PG8_SB(1, 1), b3 + hstep, voffB); PG8_STAGE(PG8_SA(1, 0), a3, voffA);
            PG8_WAIT_V(8); PG8_WAIT_L(0); PG8_BAR; PG8_MMA(1, 0, At, B0); PG8_MMA(1, 1, At, B1); PG8_BAR; PG8_SCHED;
            } else {
            PG8_LDB(B0, 0, 0); PG8_SCHED; PG8_LDA(At, 0, 0); PG8_STAGE(PG8_SA(1, 1), a1 + hstep, voffA);
            PG8_WAIT_L(8); PG8_BAR; PG8_WAIT_L(0); PG8_MMA(0, 0, At, B0); PG8_BAR; PG8_SCHED;
            PG8_LDB(B1, 0, 1); PG8_STAGE(PG8_SB(0, 0), b2, voffB);
            PG8_BAR; PG8_WAIT_L(0); PG8_MMA(0, 1, At, B1); PG8_BAR;
            PG8_LDA(At, 0, 1); PG8_STAGE(PG8_SA(0, 0), a2, voffA);
            PG8_BAR; PG8_WAIT_L(0); PG8_MMA(1, 0, At, B0); PG8_BAR; PG8_SCHED;
            PG8_STAGE(PG8_SB(0, 1), b2 + hstep, voffB);
            PG8_WAIT_V(6); PG8_BAR; PG8_MMA(1, 1, At, B1); PG8_BAR;
            PG8_LDB(B0, 1, 0); PG8_SCHED; PG8_LDA(At, 1, 0); PG8_STAGE(PG8_SA(0, 1), a2 + hstep, voffA);
            PG8_WAIT_L(8); PG8_BAR; PG8_WAIT_L(0); PG8_MMA(0, 0, At, B0); PG8_BAR; PG8_SCHED;
            PG8_LDB(B1, 1, 1); PG8_STAGE(PG8_SB(1, 0), b3, voffB);
            PG8_BAR; PG8_WAIT_L(0); PG8_MMA(0, 1, At, B1); PG8_BAR;
            PG8_LDA(At, 1, 1); PG8_STAGE(PG8_SA(1, 0), a3, voffA);
            PG8_BAR; PG8_WAIT_L(0); PG8_MMA(1, 0, At, B0); PG8_BAR; PG8_SCHED;
            PG8_STAGE(PG8_SB(1, 1), b3 + hstep, voffB);
            PG8_WAIT_V(6); PG8_BAR; PG8_MMA(1, 1, At, B1); PG8_BAR;
            }
        }
        if constexpr (ALIGN_EPI) { if (wr == 0) PG8_BAR; }
        if constexpr (!Epi::AFTER_DRAIN) { E(acc, cur, wr, wc, fr, fq); S.done(cur); }
        if (!has_next) break;
#pragma unroll
        for (int a = 0; a < 2; ++a)
#pragma unroll
            for (int b = 0; b < 2; ++b)
#pragma unroll
                for (int m = 0; m < 4; ++m)
#pragma unroll
                    for (int n = 0; n < 2; ++n) acc[a][b][m][n] = (f32x4){0.f, 0.f, 0.f, 0.f};
        cur = nxt; cA = nA; cB = nB; ++ui;
        if constexpr (ALIGN_EPI) { if (wr == 1) PG8_BAR; }
    }
    PG8_WAIT_V(0);
    if constexpr (!ALIGN_EPI) { if (wr == 0) PG8_BAR; }
    PG8_BAR;
    if constexpr (Epi::AFTER_DRAIN) { E.fused(acc, cur, wr, wc, fr, fq, lds, wid, lane); S.done(cur); }
#undef PG8_SA
#undef PG8_SB
#undef PG8_STAGE
#undef PG8_LDA
#undef PG8_LDB
#undef PG8_MMA
#undef PG8_WAIT_V
#undef PG8_WAIT_L
#undef PG8_BAR
#undef PG8_SCHED
}
}

constexpr int NWAVES = 8, NTHR = NWAVES * 64;
constexpr int DM = 4096, TP = 8192, NS = 128, MROWS = TP + NS, MPAD = 8448;
constexpr int INW = 11296, INP = 11520;
constexpr int OFF_K = 2048, OFF_V = 2560, OFF_PRE = 3072, OFF_Z = 9216, OFF_AB = 11264;
constexpr int CONVD = 6144, FF = 11008, NGU = 2 * FF;
constexpr int NCHUNK = 128, NITEM = 16 * NCHUNK;
constexpr float ALPHA = 1.189207115002721f;
constexpr float LN_EPS = 1e-5f, RMS_EPS = 1e-6f, LOG2E = 1.4426950408889634f;
constexpr float QSCALE = 0.125f * LOG2E;
constexpr size_t O_Y = 0, O_PK = 34078720, O_PV = 34144256, O_PC = 34209792, O_PD = 34228224, O_SK = 34490368, O_SV = 42878976, O_SC = 51267584, O_SD = 53626880, O_END = 87181312;

constexpr size_t MiB = 1u << 20;
constexpr size_t WS_CTL = 0, CTL_ZERO_BYTES = 1 * MiB;
constexpr size_t WS_BIASP = 1 * MiB;
constexpr size_t WS_ROPE = 2 * MiB;
constexpr size_t WS_AB = 5 * MiB;
constexpr size_t WS_GB = 6 * MiB + 512 * 1024;
constexpr size_t WS_GL = 7 * MiB + 640 * 1024;
constexpr size_t WS_SQA = 8 * MiB, WS_SQD = 9 * MiB, WS_SKD = 10 * MiB, WS_SVD = 11 * MiB;
constexpr size_t WS_WOUT = 12 * MiB, WS_WGU = 44 * MiB, WS_WDN = 216 * MiB, WS_WIN = 302 * MiB;
constexpr size_t WS_QB = 302 * MiB, WS_KB = 334 * MiB;
constexpr size_t WS_XB = 392 * MiB;
constexpr size_t WS_PROJ = 458 * MiB;
constexpr size_t WS_QH = 644 * MiB, WS_KH = 676 * MiB, WS_VH = 708 * MiB;
constexpr size_t WS_ST = 644 * MiB, WS_UNT = 708 * MiB;
constexpr size_t WS_CWN = 740 * MiB, WS_CQD = 772 * MiB, WS_CKD = 804 * MiB, WS_CAT = 836 * MiB, WS_CU = 852 * MiB;
constexpr size_t WS_FFN = 644 * MiB;
constexpr size_t WS_T2B = 526 * MiB;
constexpr size_t WS_SLAB = 916 * MiB;
constexpr size_t WS_END = 948 * MiB;
static_assert(WS_WIN + (size_t)INP * DM * 2 <= WS_XB && WS_XB + (size_t)MPAD * DM * 2 <= WS_PROJ && WS_PROJ + (size_t)MPAD * INP * 2 <= WS_QH && WS_CU + (size_t)NITEM * 64 * 128 * 4 <= WS_END && WS_FFN + (size_t)MPAD * FF * 2 <= WS_END, "ws map");
static_assert(WS_WGU + (size_t)NGU * DM * 2 <= WS_WDN && WS_WDN + (size_t)DM * FF * 2 <= WS_WIN && WS_ROPE + 8193 * 32 * 8 <= WS_AB && WS_AB + (size_t)MPAD * 32 * 4 <= WS_GB && WS_GB + TP * 32 * 4 <= WS_GL, "ws map 2");
constexpr int CW_TMO = 0, CW_CODE = 1, CW_BAR = 4096, CW_QATT = 16384, CW_QSMP = 16384 + 64, CW_QCV = 16384 + 1024, CW_XRANK = 32768;

constexpr int RING_OFF = 0, RING_BYTES = 147456, LDSCTL_OFF = RING_BYTES, MISC_OFF = LDSCTL_OFF + 320, LDS_BYTES = 163840;
#define GAS __attribute__((address_space(1)))
#define LAS __attribute__((address_space(3)))
typedef unsigned short bf16;
typedef unsigned v4u __attribute__((ext_vector_type(4)));
typedef float f32x4 __attribute__((ext_vector_type(4)));
typedef short bf16x8 __attribute__((ext_vector_type(8)));
typedef GAS unsigned gu32;
typedef GAS unsigned long long gu64;
#define RLX_AGENT __ATOMIC_RELAXED, __HIP_MEMORY_SCOPE_AGENT
#define LDS_WAIT() asm volatile("s_waitcnt lgkmcnt(0)" ::: "memory")
#define VM_WAIT() asm volatile("s_waitcnt vmcnt(0)" ::: "memory")
__device__ __forceinline__ unsigned long long rt() { return __builtin_amdgcn_s_memrealtime(); }
__device__ __forceinline__ unsigned f2bf(float f) { unsigned u = __builtin_bit_cast(unsigned, f); return (u + 0x7fffu + ((u >> 16) & 1u)) >> 16; }
__device__ __forceinline__ unsigned pk2(float lo, float hi) { return f2bf(lo) | (f2bf(hi) << 16); }

#define XB_TMO      128
#define XB_XCNT(j)  (256  + 64 * (j))
#define XB_XSUB(j)  (1280 + 64 * (j))
#define XB_XGEN(j)  (2304 + 64 * (j))
#define XB_TOP      3328
#define XB_TOPGEN   3392
#define XCD_BAR_WORDS 3456
#define XB_SPIN_CAP (1u << 18)

__device__ __forceinline__ unsigned xb_ld(unsigned* p)              { return __hip_atomic_load(p, __ATOMIC_RELAXED, __HIP_MEMORY_SCOPE_AGENT); }
__device__ __forceinline__ unsigned xb_add(unsigned* p, unsigned v) { return __hip_atomic_fetch_add(p, v, __ATOMIC_RELAXED, __HIP_MEMORY_SCOPE_AGENT); }
__device__ __forceinline__ unsigned xb_xcc_id() { return (unsigned)__builtin_amdgcn_s_getreg((3 << 11) | 20) & 0xFu; }
#define XB_SPIN(cond, bar) do { unsigned _sp = 0; while (cond) { __builtin_amdgcn_s_sleep(1); \
    if ((++_sp & 255u) == 0u) { if (xb_ld(&(bar)[XB_TMO])) break; if (_sp > XB_SPIN_CAP) { atomicAdd(&(bar)[XB_TMO], 1u); break; } } } } while (0)

struct XcdBarrier {
    unsigned* bar; unsigned x;
    volatile LAS unsigned* st;
};

__device__ __forceinline__ XcdBarrier xcd_barrier_post(unsigned* bar, volatile LAS unsigned* st) {
    XcdBarrier b; b.bar = bar; b.x = xb_xcc_id(); b.st = st;
    if (threadIdx.x == 0) (void)xb_add(&bar[XB_XCNT(b.x)], 1u);
    return b;
}
__device__ __forceinline__ void xcd_barrier_complete(unsigned* bar, unsigned x, unsigned& nloc, unsigned& nx) {
    const unsigned G = gridDim.x * gridDim.y * gridDim.z;
    unsigned sum, cnt, mine, sp = 0u;
    for (;;) {
        sum = 0u; cnt = 0u; mine = 0u;
#pragma unroll
        for (unsigned j = 0; j < 16; ++j) { const unsigned c = xb_ld(&bar[XB_XCNT(j)]); sum += c; cnt += (c > 0u) ? 1u : 0u; mine = (j == x) ? c : mine; }
        if (sum == G) break;
        __builtin_amdgcn_s_sleep(1);
        if ((++sp & 255u) == 0u) { if (xb_ld(&bar[XB_TMO])) break; if (sp > XB_SPIN_CAP) { atomicAdd(&bar[XB_TMO], 1u); break; } }
    }
    nloc = mine > 0u ? mine : 1u; nx = cnt > 0u ? cnt : 1u;
}

__device__ __forceinline__ void xcd_barrier(const XcdBarrier& b) {
    asm volatile("s_waitcnt vmcnt(0)" ::: "memory");
    __syncthreads();
    if (threadIdx.x == 0) {
        unsigned* bar = b.bar;
        __builtin_amdgcn_s_waitcnt(0);
        unsigned nloc = b.st[0], nx = b.st[1];
        if (nloc == 0u) { xcd_barrier_complete(bar, b.x, nloc, nx); b.st[0] = nloc; b.st[1] = nx; }
        const unsigned old = xb_add(&bar[XB_XSUB(b.x)], 1u);
        const unsigned gen = old / nloc;
        if (old + 1u == (gen + 1u) * nloc) {
            __builtin_amdgcn_fence(__ATOMIC_RELEASE, "agent");
            asm volatile("s_waitcnt vmcnt(0)" ::: "memory");
            const unsigned og = xb_add(&bar[XB_TOP], 1u);
            const unsigned tg = og / nx;
            if (og + 1u == (tg + 1u) * nx) xb_add(&bar[XB_TOPGEN], 1u);
            else XB_SPIN(xb_ld(&bar[XB_TOPGEN]) == tg, bar);
            __builtin_amdgcn_fence(__ATOMIC_ACQUIRE, "agent");
            xb_add(&bar[XB_XGEN(b.x)], 1u);
            asm volatile("s_waitcnt vmcnt(0)" ::: "memory");
        } else {
            XB_SPIN(xb_ld(&bar[XB_XGEN(b.x)]) == gen, bar);
            __builtin_amdgcn_fence(__ATOMIC_ACQUIRE, "agent");
            asm volatile("s_waitcnt vmcnt(0)" ::: "memory");
        }
    }
    __syncthreads();
}

typedef float f32x16 __attribute__((ext_vector_type(16)));
typedef float f32x2 __attribute__((ext_vector_type(2)));
typedef unsigned v2u __attribute__((ext_vector_type(2)));
typedef __bf16 bf16x2_t __attribute__((ext_vector_type(2)));
#define DI __device__ __forceinline__
#define MFMA32(a, b, c) __builtin_amdgcn_mfma_f32_32x32x16_bf16((a), (b), (c), 0, 0, 0)
#define MFMA16(a, b, c) __builtin_amdgcn_mfma_f32_16x16x32_bf16((a), (b), (c), 0, 0, 0)
DI unsigned cvtpk(float lo, float hi) { f32x2 v = {lo, hi}; bf16x2_t b = __builtin_convertvector(v, bf16x2_t); return __builtin_bit_cast(unsigned, b); }
DI float bf2f(unsigned short b) { return __uint_as_float((unsigned)b << 16); }
DI float bflo(unsigned w) { return __uint_as_float(w << 16); }
DI float bfhi(unsigned w) { return __uint_as_float(w & 0xffff0000u); }
DI bf16x8 pack8(const f32x4& a, const f32x4& b) { v4u p; p.x = cvtpk(a[0], a[1]); p.y = cvtpk(a[2], a[3]); p.z = cvtpk(b[0], b[1]); p.w = cvtpk(b[2], b[3]); return __builtin_bit_cast(bf16x8, p); }
DI float wave_sum(float v) {
#pragma unroll
    for (int o = 1; o < 64; o <<= 1) v += __shfl_xor(v, o);
    return v;
}
DI float wave_max(float v) {
#pragma unroll
    for (int o = 1; o < 64; o <<= 1) v = fmaxf(v, __shfl_xor(v, o));
    return v;
}
DI float row16_sum(float v) {
    v += __int_as_float(__builtin_amdgcn_update_dpp(0, __float_as_int(v), 0x128, 0xf, 0xf, false));
    v += __int_as_float(__builtin_amdgcn_update_dpp(0, __float_as_int(v), 0x124, 0xf, 0xf, false));
    v += __int_as_float(__builtin_amdgcn_update_dpp(0, __float_as_int(v), 0x122, 0xf, 0xf, false));
    v += __int_as_float(__builtin_amdgcn_update_dpp(0, __float_as_int(v), 0x121, 0xf, 0xf, false));
    return v;
}
DI float silu_f(float x) { return x * __builtin_amdgcn_rcpf(1.0f + __builtin_amdgcn_exp2f(-LOG2E * x)); }
DI float silu_acc(float x) { return x / (1.0f + __expf(-x)); }
DI int crow32(int r, int hl) { return (r & 3) + 8 * (r >> 2) + 4 * hl; }

__constant__ float ROPE_HI[32] = {1.591549367e-01f, 1.193493679e-01f, 8.949939907e-02f, 6.711508334e-02f, 5.032921210e-02f, 3.774158657e-02f, 2.830219641e-02f, 2.122365311e-02f, 1.591549441e-02f, 1.193493698e-02f, 8.949940093e-03f, 6.711508147e-03f, 5.032921210e-03f, 3.774158424e-03f, 2.830219688e-03f, 2.122365171e-03f, 1.591549488e-03f, 1.193493721e-03f, 8.949940093e-04f, 6.711508031e-04f, 5.032921326e-04f, 3.774158540e-04f, 2.830219455e-04f, 2.122365258e-04f, 1.591549371e-04f, 1.193493736e-04f, 8.949940093e-05f, 6.711508468e-05f, 5.032921035e-05f, 3.774158540e-05f, 2.830219637e-05f, 2.122365186e-05f};
__constant__ float ROPE_LO[32] = {6.420638243e-09f, 2.294664903e-09f, 2.542919653e-09f, -3.316028840e-10f, 5.173299289e-12f, -1.848551645e-09f, -5.826552019e-10f, -3.431038786e-10f, -1.029942312e-10f, 4.320196978e-11f, 6.802745173e-11f, 1.531042237e-10f, 5.173298855e-13f, 4.797548470e-11f, -1.048316503e-10f, 1.053879969e-10f, -5.686555046e-11f, -1.896286773e-11f, 6.802744999e-12f, 2.695195456e-11f, -1.158979943e-11f, -6.843983713e-12f, 1.279990003e-11f, 1.807650600e-12f, 5.954976963e-12f, -3.351478166e-12f, 6.802744674e-13f, -1.670379113e-12f, 1.751403167e-12f, -6.843983930e-13f, -5.389994549e-13f, 9.083608431e-13f};

struct Args { const float* in[21]; float* out; unsigned char* ws; int ph_lo, ph_hi, li, pad; };
enum { I_XP = 0, I_XS, I_CK, I_CV, I_SCONV, I_SDELTA, I_WIN, I_BATTN, I_SINKS, I_WCONV, I_ALOG, I_DTB, I_NORMW, I_WOUT, I_LN1G, I_LN1B, I_WGATE, I_WUP, I_WDOWN, I_LN2G, I_LN2B };

template <int MODE> DI int rowmap(int n) { return MODE == 0 ? n : (256 * (n >> 7) + (n & 127) + (MODE == 2 ? 128 : 0)); }
template <int MODE> DI void p0_tile(const float* __restrict__ W, int N, int K, bf16* __restrict__ WT, LAS unsigned short* scr, int kb, int nb, int lane) {
    const int k0 = 64 * kb, n0 = 64 * nb, n = n0 + lane; const bool ok = n < N;
    const float* src = W + (size_t)k0 * N + (ok ? n : 0);
#pragma unroll 32
    for (int kk = 0; kk < 64; ++kk) { const float v = __builtin_nontemporal_load(src + (size_t)kk * N); scr[kk * 66 + lane] = (unsigned short)f2bf(ok ? v : 0.f); }
    LDS_WAIT(); asm volatile("" ::: "memory");
    const int c = lane & 7, nn = lane >> 3;
#pragma unroll
    for (int p = 0; p < 8; ++p) { const int nl = nn + 8 * p, ng = n0 + nl;
        const LAS unsigned short* s = scr + (8 * c) * 66 + nl;
        v4u o; o.x = (unsigned)s[0] | ((unsigned)s[66] << 16); o.y = (unsigned)s[2 * 66] | ((unsigned)s[3 * 66] << 16); o.z = (unsigned)s[4 * 66] | ((unsigned)s[5 * 66] << 16); o.w = (unsigned)s[6 * 66] | ((unsigned)s[7 * 66] << 16);
        if (ng < N) *(v4u*)(WT + (size_t)rowmap<MODE>(ng) * K + k0 + 8 * c) = o; }
    LDS_WAIT(); asm volatile("" ::: "memory");
}
constexpr int CV_T_IN = 64 * 177, CV_T_OUT = 64 * 64, CV_T_G = 64 * 172, CV_T_DN = 172 * 64;
constexpr int CV_T3 = CV_T_OUT + CV_T_DN, CV_T4 = 2 * CV_T_G;
DI void cv_tile3(const Args& A, LAS unsigned short* scr, int r, int lane) {
    if (r < CV_T_OUT) p0_tile<0>(A.in[I_WOUT], DM, DM, (bf16*)(A.ws + WS_WOUT), scr, r / 64, r % 64, lane);
    else { r -= CV_T_OUT; p0_tile<0>(A.in[I_WDOWN], DM, FF, (bf16*)(A.ws + WS_WDN), scr, r / 64, r % 64, lane); }
}
DI void cv_tile4(const Args& A, LAS unsigned short* scr, int r, int lane) {
    if (r < CV_T_G) p0_tile<1>(A.in[I_WGATE], FF, DM, (bf16*)(A.ws + WS_WGU), scr, r / 172, r % 172, lane);
    else { r -= CV_T_G; p0_tile<2>(A.in[I_WUP], FF, DM, (bf16*)(A.ws + WS_WGU), scr, r / 172, r % 172, lane); }
}
DI void cv_pull3(const Args& A, LAS unsigned char* lds, gu32* ctr, int t0, int t1, int wave, int lane) {
    LAS unsigned short* scr = (LAS unsigned short*)(lds + RING_OFF + wave * 8448);
    for (;;) { int b = 0; if (lane == 0) b = (int)__hip_atomic_fetch_add(ctr, 4u, RLX_AGENT); b = t0 + __builtin_amdgcn_readfirstlane(b);
        if (b >= t1) break;
        for (int r = b; r < b + 4 && r < t1; ++r) cv_tile3(A, scr, r, lane); }
}
DI void p0_prologue(const Args& A, LAS unsigned char* lds, int gw, int NGW, int wave, int lane) {
    unsigned char* ws = A.ws;
    LAS unsigned short* scr = (LAS unsigned short*)(lds + RING_OFF + wave * 8448);
    for (int it = gw; it < CV_T_IN + CV_T4; it += NGW) {
        if (it < CV_T4) cv_tile4(A, scr, it, lane);
        else { const int r = it - CV_T4; p0_tile<0>(A.in[I_WIN], INW, DM, (bf16*)(ws + WS_WIN), scr, r / 177, r % 177, lane); } }
    for (int m = gw; m < MPAD + (INP - INW); m += NGW) {
        if (m < MPAD) {
            v2u* o = (v2u*)((bf16*)(ws + WS_XB) + (size_t)m * DM) + lane;
            if (m < MROWS) { const f32x4* xr = (const f32x4*)(m < TP ? A.in[I_XP] + (size_t)m * DM : A.in[I_XS] + (size_t)(m - TP) * DM) + lane;
#pragma unroll 8
                for (int j = 0; j < 16; ++j) { const f32x4 v = __builtin_nontemporal_load(xr + 64 * j); v2u w; w.x = cvtpk(v[0], v[1]); w.y = cvtpk(v[2], v[3]); o[64 * j] = w; } }
            else {
#pragma unroll 8
                for (int j = 0; j < 16; ++j) o[64 * j] = (v2u){0u, 0u}; }
        } else {
            v4u* o = (v4u*)((bf16*)(ws + WS_WIN) + (size_t)(INW + (m - MPAD)) * DM) + lane;
#pragma unroll
            for (int j = 0; j < 8; ++j) o[64 * j] = (v4u){0u, 0u, 0u, 0u};
        }
    }
    const int gt = gw * 64 + lane, NGT = NGW * 64;
    for (int i = gt; i < INP; i += NGT) ((float*)(ws + WS_BIASP))[i] = i < 3072 ? A.in[I_BATTN][i] : 0.f;
    for (int i = gt; i < 8193 * 32; i += NGT) { const int pos = i >> 5, f = i & 31; const float p = (float)pos, hi = ROPE_HI[f];
        const float r0 = p * hi, e0 = __builtin_fmaf(p, hi, -r0) + p * ROPE_LO[f]; float fr = r0 - __builtin_floorf(r0) + e0;
        f32x2 cs; cs.x = __builtin_amdgcn_cosf(fr); cs.y = __builtin_amdgcn_sinf(fr); ((f32x2*)(ws + WS_ROPE))[i] = cs; }
}

DI void p2_token(const Args& A, int row, int lane) {
    unsigned char* ws = A.ws; float* out = A.out;
    const bool smp = row >= TP; const int n = row - TP; const int pos = smp ? TP : row;
    const bf16* pr = (const bf16*)(ws + WS_PROJ) + (size_t)row * INP;
    const int part = lane & 3, hs = lane >> 2, d0 = 8 * part;
    f32x4 cs[4];
    { const f32x4* tp = (const f32x4*)((const float*)(ws + WS_ROPE) + ((size_t)pos * 32 + d0) * 2);
#pragma unroll
      for (int j = 0; j < 4; ++j) cs[j] = tp[j]; }
#pragma unroll
    for (int ps = 0; ps < 3; ++ps) { const int hh = 16 * ps + hs;
        if (hh < 40) {
            const v4u a = *(const v4u*)(pr + hh * 64 + d0), b = *(const v4u*)(pr + hh * 64 + 32 + d0);
            float x1[8], x2[8], o1[8], o2[8];
#pragma unroll
            for (int j = 0; j < 4; ++j) { x1[2 * j] = bflo(a[j]); x1[2 * j + 1] = bfhi(a[j]); x2[2 * j] = bflo(b[j]); x2[2 * j + 1] = bfhi(b[j]); }
#pragma unroll
            for (int j = 0; j < 8; ++j) { const float c = cs[j >> 1][(j & 1) * 2], s = cs[j >> 1][(j & 1) * 2 + 1]; o1[j] = x1[j] * c - x2[j] * s; o2[j] = x2[j] * c + x1[j] * s; }
            if (hh < 32) {
                if (!smp) { bf16* q = (bf16*)(ws + WS_QB) + (size_t)row * 2048 + hh * 64 + d0;
                    v4u w1, w2;
#pragma unroll
                    for (int j = 0; j < 4; ++j) { w1[j] = cvtpk(o1[2 * j] * QSCALE, o1[2 * j + 1] * QSCALE); w2[j] = cvtpk(o2[2 * j] * QSCALE, o2[2 * j + 1] * QSCALE); }
                    *(v4u*)q = w1; *(v4u*)(q + 32) = w2;
                } else { float* q = (float*)(ws + WS_SQA) + (size_t)n * 2048 + hh * 64 + d0;
#pragma unroll
                    for (int j = 0; j < 8; ++j) { q[j] = o1[j] * QSCALE; q[32 + j] = o2[j] * QSCALE; } }
            } else { const int kvh = hh - 32;
                if (!smp) { bf16* k = (bf16*)(ws + WS_KB) + (size_t)row * 512 + kvh * 64 + d0;
                    v4u w1, w2;
#pragma unroll
                    for (int j = 0; j < 4; ++j) { w1[j] = cvtpk(o1[2 * j], o1[2 * j + 1]); w2[j] = cvtpk(o2[2 * j], o2[2 * j + 1]); }
                    *(v4u*)k = w1; *(v4u*)(k + 32) = w2; }
                if (smp || row >= TP - 128) { float* k = smp ? out + O_SK + ((size_t)n * 128 + 127) * 512 + kvh * 64 + d0 : out + O_PK + (size_t)(row - (TP - 128)) * 512 + kvh * 64 + d0;
#pragma unroll
                    for (int j = 0; j < 8; ++j) { k[j] = o1[j]; k[32 + j] = o2[j]; } }
            }
        }
    }
    if (smp || row >= TP - 128) { float* v = smp ? out + O_SV + ((size_t)n * 128 + 127) * 512 : out + O_PV + (size_t)(row - (TP - 128)) * 512;
        const v4u a = *(const v4u*)(pr + OFF_V + 8 * lane);
#pragma unroll
        for (int j = 0; j < 4; ++j) { v[8 * lane + 2 * j] = bflo(a[j]); v[8 * lane + 2 * j + 1] = bfhi(a[j]); } }
    if (smp && lane < 16) {   const float* ab = (const float*)(ws + WS_AB) + (size_t)row * 32; const float a = ab[lane] + A.in[I_DTB][lane], b = ab[16 + lane];
        const float sp = a > 20.f ? a : log1pf(expf(a)); const float g = -expf(A.in[I_ALOG][lane]) * sp; const float be = 1.0f / (1.0f + expf(-b));
        if (!smp) { float* gb = (float*)(ws + WS_GB) + (size_t)row * 32; gb[lane] = g; gb[16 + lane] = be; }
        else { float* gs = (float*)(ws + WS_SQA); (void)gs; float* gb2 = (float*)(ws + WS_GL) + 4096 + (size_t)n * 32; gb2[lane] = g; gb2[16 + lane] = be; } }
}

DI void p2_conv4(const Args& A, int grp, int ps, int lane) {
    unsigned char* ws = A.ws; float* out = A.out;
    const int t0 = 4 * grp, c0 = 512 * ps + 8 * lane;
    const bf16* pr = (const bf16*)(ws + WS_PROJ) + OFF_PRE + c0;
    v4u xr[7];
#pragma unroll
    for (int j = 0; j < 7; ++j) { const int r = t0 - 3 + j; xr[j] = r >= 0 ? *(const v4u*)(pr + (size_t)r * INP) : (v4u){0u, 0u, 0u, 0u}; }
    f32x4 w[4][2];
#pragma unroll
    for (int j = 0; j < 4; ++j) { const f32x4* wp = (const f32x4*)(A.in[I_WCONV] + (size_t)j * CONVD + c0); w[j][0] = wp[0]; w[j][1] = wp[1]; }
    float x[7][8];
#pragma unroll
    for (int j = 0; j < 7; ++j)
#pragma unroll
        for (int e = 0; e < 4; ++e) { x[j][2 * e] = bflo(xr[j][e]); x[j][2 * e + 1] = bfhi(xr[j][e]); }
    const int cc = (ps & 3) * 512 + 8 * lane;
    bf16* dst = (bf16*)(ws + (ps < 4 ? WS_QH : (ps < 8 ? WS_KH : WS_VH))) + (size_t)t0 * 2048 + cc;
#pragma unroll
    for (int t = 0; t < 4; ++t) { float y[8]; float ss = 0.f;
#pragma unroll
        for (int e = 0; e < 8; ++e) { float a = 0.f;
#pragma unroll
            for (int j = 0; j < 4; ++j) a += w[j][e >> 2][e & 3] * x[t + j][e];
            y[e] = silu_acc(a); ss += y[e] * y[e]; }
        if (ps < 8) { ss = row16_sum(ss);
            const float rn = (1.0f / sqrtf(ss + RMS_EPS)) * (ps < 4 ? 0.08838834764831845f : 1.0f);
#pragma unroll
            for (int e = 0; e < 8; ++e) y[e] *= rn; }
        v4u o;
#pragma unroll
        for (int e = 0; e < 4; ++e) o[e] = cvtpk(y[2 * e], y[2 * e + 1]);
        *(v4u*)(dst + (size_t)t * 2048) = o;
        if (t0 + t >= TP - 3) { float* d = out + O_PC + (size_t)(t0 + t - (TP - 3)) * CONVD + c0;
            *(f32x4*)d = (f32x4){x[t + 3][0], x[t + 3][1], x[t + 3][2], x[t + 3][3]}; *(f32x4*)(d + 4) = (f32x4){x[t + 3][4], x[t + 3][5], x[t + 3][6], x[t + 3][7]}; }
    }
}
DI void p2_convs(const Args& A, int n, int ps, int lane) {
    unsigned char* ws = A.ws; float* out = A.out;
    const int c0 = 512 * ps + 8 * lane;
    float x[4][8];
#pragma unroll
    for (int j = 0; j < 3; ++j) { const f32x4* sp = (const f32x4*)(A.in[I_SCONV] + ((size_t)n * 3 + j) * CONVD + c0); const f32x4 s0 = sp[0], s1 = sp[1];
#pragma unroll
        for (int e = 0; e < 4; ++e) { x[j][e] = s0[e]; x[j][4 + e] = s1[e]; } }
    { const v4u a = *(const v4u*)((const bf16*)(ws + WS_PROJ) + (size_t)(TP + n) * INP + OFF_PRE + c0);
#pragma unroll
      for (int e = 0; e < 4; ++e) { x[3][2 * e] = bflo(a[e]); x[3][2 * e + 1] = bfhi(a[e]); } }
    float y[8]; float ss = 0.f;
#pragma unroll
    for (int e = 0; e < 8; ++e) y[e] = 0.f;
#pragma unroll
    for (int j = 0; j < 4; ++j) { const f32x4* wp = (const f32x4*)(A.in[I_WCONV] + (size_t)j * CONVD + c0); const f32x4 w0 = wp[0], w1 = wp[1];
#pragma unroll
        for (int e = 0; e < 4; ++e) { y[e] += w0[e] * x[j][e]; y[4 + e] += w1[e] * x[j][4 + e]; } }
#pragma unroll
    for (int e = 0; e < 8; ++e) { y[e] = silu_acc(y[e]); ss += y[e] * y[e]; }
    if (ps < 8) { ss = row16_sum(ss);
        const float rn = (1.0f / sqrtf(ss + RMS_EPS)) * (ps < 4 ? 0.08838834764831845f : 1.0f);
#pragma unroll
        for (int e = 0; e < 8; ++e) y[e] *= rn; }
    float* dst = (float*)(ws + (ps < 4 ? WS_SQD : (ps < 8 ? WS_SKD : WS_SVD))) + (size_t)n * 2048 + (ps & 3) * 512 + 8 * lane;
    *(f32x4*)dst = (f32x4){y[0], y[1], y[2], y[3]}; *(f32x4*)(dst + 4) = (f32x4){y[4], y[5], y[6], y[7]};
    float* d = out + O_SC + (size_t)n * 3 * CONVD + c0;
#pragma unroll
    for (int j = 0; j < 3; ++j) { *(f32x4*)(d + (size_t)j * CONVD) = (f32x4){x[j + 1][0], x[j + 1][1], x[j + 1][2], x[j + 1][3]}; *(f32x4*)(d + (size_t)j * CONVD + 4) = (f32x4){x[j + 1][4], x[j + 1][5], x[j + 1][6], x[j + 1][7]}; }
}

constexpr size_t WS_GBS = WS_GL + 16384;

DI void p3_pair(const Args& A, int it0, LAS unsigned char* ldsw, int tid, int wave, int lane) {
    unsigned char* ws = A.ws;
    const int half = tid >> 8, t = tid & 255, w4 = wave & 3, it = it0 + half;
    const int hh = it >> 7, ck = it & 127, t0 = ck * 64;
    LAS unsigned char* lds = ldsw + half * 53248;
    LAS unsigned short* KH = (LAS unsigned short*)(lds);
    LAS unsigned short* QH = (LAS unsigned short*)(lds + 17408);
    LAS float* AMT = (LAS float*)(lds + 34816);
    LAS float* CUM = (LAS float*)(lds + 52224);
    LAS float* BET = CUM + 64;
    {   const int g4 = t >> 4, ch = t & 15;
#pragma unroll 1
        for (int which = 0; which < 2; ++which) {
            const bf16* pr = (const bf16*)(ws + WS_PROJ) + OFF_PRE + which * 2048 + hh * 128 + 8 * ch; const float* wc = A.in[I_WCONV] + which * 2048 + hh * 128 + 8 * ch;
            v4u xr[7];
#pragma unroll
            for (int j = 0; j < 7; ++j) { const int row = t0 + 4 * g4 - 3 + j; xr[j] = row >= 0 ? *(const v4u*)(pr + (size_t)row * INP) : (v4u){0u, 0u, 0u, 0u}; }
            f32x4 w[4][2];
#pragma unroll
            for (int j = 0; j < 4; ++j) { w[j][0] = *(const f32x4*)(wc + (size_t)j * CONVD); w[j][1] = *(const f32x4*)(wc + (size_t)j * CONVD + 4); }
            LAS unsigned short* dst = (which ? KH : QH) + (4 * g4) * 136 + ch * 8;
#pragma unroll
            for (int tt = 0; tt < 4; ++tt) { float y[8]; float ss = 0.f;
#pragma unroll
                for (int e = 0; e < 8; ++e) { float a = 0.f;
#pragma unroll
                    for (int j = 0; j < 4; ++j) { const unsigned wd = xr[tt + j][e >> 1]; a += w[j][e >> 2][e & 3] * ((e & 1) ? bfhi(wd) : bflo(wd)); }
                    y[e] = silu_acc(a); ss += y[e] * y[e]; }
                ss = row16_sum(ss);
                const float rn = (1.0f / sqrtf(ss + RMS_EPS)) * (which == 0 ? 0.08838834764831845f : 1.0f);
                v4u o;
#pragma unroll
                for (int e = 0; e < 4; ++e) o[e] = cvtpk(y[2 * e] * rn, y[2 * e + 1] * rn);
                *(LAS v4u*)(dst + tt * 136) = o;
                if (ck == NCHUNK - 1 && 4 * g4 + tt >= 61) { float* d = A.out + O_PC + (size_t)(4 * g4 + tt - 61) * CONVD + which * 2048 + hh * 128 + 8 * ch; const v4u rw = xr[tt + 3];
                    *(f32x4*)d = (f32x4){bflo(rw[0]), bfhi(rw[0]), bflo(rw[1]), bfhi(rw[1])}; *(f32x4*)(d + 4) = (f32x4){bflo(rw[2]), bfhi(rw[2]), bflo(rw[3]), bfhi(rw[3])}; }
            }
        }
    }
    __builtin_amdgcn_sched_barrier(0);
    float x[64];
    if (t >= 128) { const int c = t - 128; const bf16* pv = (const bf16*)(ws + WS_PROJ) + OFF_PRE + 4096 + hh * 128 + c; const float* wc = A.in[I_WCONV] + 4096 + hh * 128 + c;
        const float w0 = wc[0], w1 = wc[CONVD], w2 = wc[2 * CONVD], w3 = wc[3 * CONVD];
        float e0, e1, e2;
        { const int r0 = t0 - 3; e0 = r0 >= 0 ? bf2f(pv[(size_t)r0 * INP]) : 0.f; e1 = r0 + 1 >= 0 ? bf2f(pv[(size_t)(r0 + 1) * INP]) : 0.f; e2 = r0 + 2 >= 0 ? bf2f(pv[(size_t)(r0 + 2) * INP]) : 0.f; }
#pragma unroll
        for (int i = 0; i < 64; ++i) x[i] = bf2f(pv[(size_t)(t0 + i) * INP]);
        if (ck == NCHUNK - 1) { float* d = A.out + O_PC + 4096 + hh * 128 + c; d[0] = x[61]; d[CONVD] = x[62]; d[2 * CONVD] = x[63]; }
#pragma unroll
        for (int i = 63; i >= 0; --i) { const float a = i >= 3 ? x[i - 3] : (i == 2 ? e2 : (i == 1 ? e1 : e0)), b = i >= 2 ? x[i - 2] : (i == 1 ? e2 : e1), cc2 = i >= 1 ? x[i - 1] : e2;
            x[i] = silu_acc(w0 * a + w1 * b + w2 * cc2 + w3 * x[i]); }
    }
    if (t < 64) {
        const float* ab = (const float*)(ws + WS_AB) + (size_t)(t0 + t) * 32; const float a = ab[hh] + A.in[I_DTB][hh], bb = ab[16 + hh];
        const float sp = a > 20.f ? a : log1pf(expf(a)); float c = -expf(A.in[I_ALOG][hh]) * sp;
#pragma unroll
        for (int o = 1; o < 64; o <<= 1) { const float tt = __shfl_up(c, o); if (lane >= o) c += tt; }
        CUM[t] = c; BET[t] = 1.0f / (1.0f + expf(-bb)); }
    __syncthreads();
    {
        const int ti = (w4 >> 1) & 1, tj = w4 & 1, l31 = lane & 31, hl = lane >> 5;
        const LAS unsigned short* Bs = KH + (32 * tj + l31) * 136 + 8 * hl;
        const int j = 32 * tj + l31; const float cj = CUM[j];
        bf16* att = (bf16*)(ws + WS_CAT) + (size_t)it * 4096;
#pragma unroll
        for (int which = 0; which < 2; ++which) {
            const LAS unsigned short* As = (which ? QH : KH) + (32 * ti + l31) * 136 + 8 * hl;
            f32x16 xx;
#pragma unroll
            for (int r = 0; r < 16; ++r) xx[r] = 0.f;
#pragma unroll
            for (int s = 0; s < 8; ++s) { const bf16x8 a = *(const LAS bf16x8*)(As + 16 * s), b = *(const LAS bf16x8*)(Bs + 16 * s); xx = MFMA32(a, b, xx); }
#pragma unroll
            for (int r = 0; r < 16; ++r) { const int i = 32 * ti + crow32(r, hl); const float dec = __expf(fminf(CUM[i] - cj, 0.f));
                if (which == 0) { if (i > j) AMT[j * 68 + i] = BET[i] * xx[r] * dec; }
                else { const float v = i >= j ? xx[r] * dec : 0.f; att[i * 64 + j] = (bf16)f2bf(v); } }
        }
    }
    __syncthreads();
    if (t < 128) { const int c = t; const float cl = CUM[63];
        bf16* kd = (bf16*)(ws + WS_CKD) + (size_t)it * 8192 + c * 64;
#pragma unroll
        for (int g = 0; g < 8; ++g) { float kv[8];
#pragma unroll
            for (int e = 0; e < 8; ++e) { const int tt = 8 * g + e; const float k = bf2f(KH[tt * 136 + c]); const float cu = CUM[tt]; kv[e] = k * __expf(cl - cu); x[tt] = k * BET[tt] * __expf(cu); }
            v4u w; w.x = cvtpk(kv[0], kv[1]); w.y = cvtpk(kv[2], kv[3]); w.z = cvtpk(kv[4], kv[5]); w.w = cvtpk(kv[6], kv[7]); *(v4u*)(kd + 8 * g) = w; }
    } else {
#pragma unroll
        for (int i = 0; i < 64; ++i) x[i] *= BET[i];
    }
#pragma unroll
    for (int j = 0; j < 63; ++j) { const float xj = x[j];
#pragma unroll
        for (int a4 = (j + 1) / 4; a4 < 16; ++a4) { const f32x4 av = *(const LAS f32x4*)(AMT + j * 68 + 4 * a4);
#pragma unroll
            for (int e = 0; e < 4; ++e) { const int i = 4 * a4 + e; if (i > j) x[i] -= av[e] * xj; } } }
    if (t < 128) { bf16* wn = (bf16*)(ws + WS_CWN) + (size_t)it * 8192 + t;
#pragma unroll
        for (int i = 0; i < 64; ++i) wn[i * 128] = (bf16)f2bf(-x[i]);
    } else { float* u = (float*)(ws + WS_CU) + (size_t)it * 8192 + (t - 128);
#pragma unroll
        for (int i = 0; i < 64; ++i) u[i * 128] = x[i];
    }
    {
        bf16* qd = (bf16*)(ws + WS_CQD) + (size_t)it * 8192;
#pragma unroll
        for (int p = 0; p < 4; ++p) { const int c = t + 256 * p, r = c >> 4, ch = c & 15; const float ga = __expf(CUM[r]);
            const v4u a = *(const LAS v4u*)(QH + r * 136 + ch * 8); v4u w;
#pragma unroll
            for (int e = 0; e < 4; ++e) w[e] = cvtpk(bflo(a[e]) * ga, bfhi(a[e]) * ga);
            *(v4u*)(qd + r * 128 + ch * 8) = w; }
        if (t == 0) ((float*)(ws + WS_GL))[it] = __expf(CUM[63]);
    }
    __syncthreads();
}

DI float rdlane(float v, int l) { return __int_as_float(__builtin_amdgcn_readlane(__float_as_int(v), l)); }
constexpr int SCAN_NCW = 2;
constexpr int SCAN_SLOT = 32768 + 4096 * SCAN_NCW, SCAN_NS = 3, SCAN_PIECES = 8 + SCAN_NCW;
DI void p4_scan_wg(const Args& A, int item, LAS unsigned char* lds, int wave, int lane) {
    unsigned char* ws = A.ws;
#if defined(PROBE_MASK)
    const bool x_nost = A.pad & 16, x_nocomp = A.pad & 32, x_noload = A.pad & 64;
#else
    constexpr bool x_nost = false, x_nocomp = false, x_noload = false;
#endif
    constexpr int NPART = 8 / SCAN_NCW, URB = 64 * SCAN_NCW, UCPR = 4 * SCAN_NCW, URPP = 1024 / URB;
    const int hh = item / NPART, hf = item % NPART;
    const unsigned char* Wn = ws + WS_CWN + (size_t)hh * 128 * 16384; const unsigned char* Kd = ws + WS_CKD + (size_t)hh * 128 * 16384; const unsigned char* U = ws + WS_CU + (size_t)hh * 128 * 32768 + hf * URB;
    if (wave >= 4) {
        const int lj = wave - 4;
        unsigned off[SCAN_PIECES];
#pragma unroll
        for (int i = 0; i < SCAN_PIECES; ++i) { const int p = lj + 4 * i;
            if (i < 4) { const int row = 4 * p + (lane >> 4), pos = lane & 15, f = (row & 3) | (((row >> 3) & 3) << 2); off[i] = (unsigned)(row * 256 + 16 * (pos ^ f)); }
            else if (i < 8) { const int pp = p - 16, row = 8 * pp + (lane >> 3), pos = lane & 7, f = ((row >> 1) & 1) | (((row >> 3) & 3) << 1); off[i] = (unsigned)(row * 128 + 16 * (pos ^ f)); }
            else { const int pp = p - 32, row = URPP * pp + lane / UCPR, pos = lane % UCPR, f = UCPR >= 8 ? ((row >> 3) & 1) << 2 : 0; off[i] = (unsigned)(row * 512 + 16 * (pos ^ f)); } }
        v4u buf[2][SCAN_PIECES];
#define SCAN_LD(c, R) do { const unsigned char* w_ = Wn + (size_t)(c) * 16384; const unsigned char* k_ = Kd + (size_t)(c) * 16384; const unsigned char* u_ = U + (size_t)(c) * 32768; \
        _Pragma("unroll") for (int i = 0; i < 4; ++i) buf[R][i] = *(const v4u*)(w_ + off[i]); \
        _Pragma("unroll") for (int i = 4; i < 8; ++i) buf[R][i] = *(const v4u*)(k_ + off[i]); \
        _Pragma("unroll") for (int i = 8; i < SCAN_PIECES; ++i) buf[R][i] = *(const v4u*)(u_ + off[i]); } while (0)
#define SCAN_ST(c, R) do { LAS unsigned char* sb_ = lds + ((c) % SCAN_NS) * SCAN_SLOT + 1024 * lj + 16 * lane; \
        _Pragma("unroll") for (int i = 0; i < 4; ++i) *(LAS v4u*)(sb_ + 4096 * i) = buf[R][i]; \
        _Pragma("unroll") for (int i = 4; i < 8; ++i) *(LAS v4u*)(sb_ + 16384 + 4096 * (i - 4)) = buf[R][i]; \
        _Pragma("unroll") for (int i = 8; i < SCAN_PIECES; ++i) *(LAS v4u*)(sb_ + 32768 + 4096 * (i - 8)) = buf[R][i]; } while (0)
        if (x_noload) { for (int b = 0; b < NCHUNK + 1; ++b) { asm volatile("" ::: "memory"); __builtin_amdgcn_s_barrier(); } return; }
        SCAN_LD(0, 0); SCAN_LD(1, 1); SCAN_ST(0, 0); SCAN_LD(2, 0); SCAN_ST(1, 1); SCAN_LD(3, 1);
        asm volatile("s_waitcnt lgkmcnt(0)" ::: "memory"); __builtin_amdgcn_s_barrier(); asm volatile("" ::: "memory");
#pragma unroll 1
        for (int c2 = 0; c2 < NCHUNK; c2 += 2) {
#define SCAN_STEP(u) do { const int ck = c2 + (u); if (ck + 2 < NCHUNK) { SCAN_ST(ck + 2, (u)); if (ck + 4 < NCHUNK) SCAN_LD(ck + 4, (u)); } \
            asm volatile("s_waitcnt lgkmcnt(0)" ::: "memory"); __builtin_amdgcn_s_barrier(); asm volatile("" ::: "memory"); } while (0)
            SCAN_STEP(0); SCAN_STEP(1);
#undef SCAN_STEP
        }
#undef SCAN_LD
#undef SCAN_ST
    } else if (wave >= SCAN_NCW) {
        for (int b = 0; b < NCHUNK + 1; ++b) { asm volatile("" ::: "memory"); __builtin_amdgcn_s_barrier(); }
    } else {
        const int q = lane >> 4, cc = lane & 15, cs = hf * SCAN_NCW + wave;
        const int rslot = 8 * (cc >> 2) + (cc & 3);
        const int fK = ((cc >> 1) & 1) | ((cc >> 2) << 1);
        f32x4 S[8];
#pragma unroll
        for (int m = 0; m < 8; ++m) S[m] = (f32x4){0.f, 0.f, 0.f, 0.f};
        const float* GL = (const float*)(ws + WS_GL) + hh * 128; const float gl0 = GL[lane], gl1 = GL[64 + lane];
        bf16* ST = (bf16*)(ws + WS_ST) + ((size_t)hh * 128 * 128 + cs * 16 + cc) * 128 + 8 * q;
        bf16* UT = (bf16*)(ws + WS_UNT) + ((size_t)hh * 128 * 128 + cs * 16 + cc) * 64 + 8 * q;
        if (x_nocomp) { for (int b = 0; b < NCHUNK + 1; ++b) { asm volatile("" ::: "memory"); __builtin_amdgcn_s_barrier(); } return; }
        asm volatile("s_waitcnt vmcnt(0)" ::: "memory"); __builtin_amdgcn_s_barrier(); asm volatile("" ::: "memory");
#pragma unroll 1
        for (int ck = 0; ck < NCHUNK; ++ck) {
            const LAS unsigned char* sb = lds + (ck % SCAN_NS) * SCAN_SLOT;
            bf16x8 Sb[4];
#pragma unroll
            for (int s = 0; s < 4; ++s) { Sb[s] = pack8(S[2 * s], S[2 * s + 1]); if (!x_nost) *(bf16x8*)(ST + (size_t)ck * 16384 + 32 * s) = Sb[s]; }
            f32x4 P[4];
#pragma unroll
            for (int mt = 0; mt < 4; ++mt) { const int tb = 32 * (mt >> 1) + 8 * q + 4 * (mt & 1);
#pragma unroll
                for (int r = 0; r < 4; ++r) { const int row = tb + r; P[mt][r] = *(const LAS float*)(sb + 32768 + row * URB + 16 * ((4 * wave + (cc >> 2)) ^ (UCPR >= 8 ? ((row >> 3) & 1) << 2 : 0)) + 4 * (cc & 3)); } }
#pragma unroll
            for (int mt = 0; mt < 4; ++mt) { const int row = 32 * (mt >> 1) + 4 * (mt & 1) + rslot;
#pragma unroll
                for (int s = 0; s < 4; ++s) P[mt] = MFMA16(*(const LAS bf16x8*)(sb + row * 256 + 16 * ((4 * s + q) ^ cc)), Sb[s], P[mt]); }
            bf16x8 Ub[2]; Ub[0] = pack8(P[0], P[1]); Ub[1] = pack8(P[2], P[3]);
            if (!x_nost) { *(bf16x8*)(UT + (size_t)ck * 8192) = Ub[0]; *(bf16x8*)(UT + (size_t)ck * 8192 + 32) = Ub[1]; }
            const float gl = rdlane(ck < 64 ? gl0 : gl1, ck & 63);
#pragma unroll
            for (int m = 0; m < 8; ++m) { const int row = 32 * (m >> 1) + 4 * (m & 1) + rslot; S[m] = S[m] * gl;
#pragma unroll
                for (int s = 0; s < 2; ++s) S[m] = MFMA16(*(const LAS bf16x8*)(sb + 16384 + row * 128 + 16 * ((4 * s + q) ^ fK)), Ub[s], S[m]); }
            asm volatile("s_waitcnt lgkmcnt(0)" ::: "memory"); __builtin_amdgcn_s_barrier(); asm volatile("" ::: "memory");
        }
        float* pd = A.out + O_PD + (size_t)hh * 128 * 128 + cs * 16 + cc;
        if (!x_nost)
#pragma unroll
        for (int m = 0; m < 8; ++m) { const int db = 32 * (m >> 1) + 8 * q + 4 * (m & 1);
#pragma unroll
            for (int r = 0; r < 4; ++r) pd[(db + r) * 128] = S[m][r]; }
    }
}

DI void p4_attn(const Args& A, int item, int lane) {
    unsigned char* ws = A.ws;
    const int qt = item >> 5, h = item & 31, kvh = h >> 2, l31 = lane & 31, hl = lane >> 5;
    const int qpos = 32 * qt + l31;
    const bf16* Qb = (const bf16*)(ws + WS_QB) + (size_t)qpos * 2048 + h * 64 + 8 * hl;
    bf16x8 qf[4];
#pragma unroll
    for (int s = 0; s < 4; ++s) qf[s] = *(const bf16x8*)(Qb + 16 * s);
    const float sink2 = A.in[I_SINKS][h] * LOG2E;
    float mx = sink2;
    f32x16 sc[5];
#pragma unroll
    for (int kk = 0; kk < 5; ++kk) { const int kt = qt - 4 + kk;
        f32x16 x;
#pragma unroll
        for (int r = 0; r < 16; ++r) x[r] = 0.f;
        if (kt >= 0) { const bf16* Kb = (const bf16*)(ws + WS_KB) + (size_t)(32 * kt + l31) * 512 + kvh * 64 + 8 * hl;
#pragma unroll
            for (int s = 0; s < 4; ++s) x = MFMA32(*(const bf16x8*)(Kb + 16 * s), qf[s], x); }
#pragma unroll
        for (int r = 0; r < 16; ++r) { const int diff = qpos - (32 * kt + crow32(r, hl)); const bool ok = (kt >= 0) && diff >= 0 && diff < 128; x[r] = ok ? x[r] : -INFINITY; mx = fmaxf(mx, x[r]); }
        sc[kk] = x; }
    mx = fmaxf(mx, __shfl_xor(mx, 32));
    float l = 0.f;
#pragma unroll
    for (int kk = 0; kk < 5; ++kk)
#pragma unroll
        for (int r = 0; r < 16; ++r) { const float p = __builtin_amdgcn_exp2f(sc[kk][r] - mx); sc[kk][r] = p; l += p; }
    l += __shfl_xor(l, 32); l += __builtin_amdgcn_exp2f(sink2 - mx);
    f32x16 o0, o1;
#pragma unroll
    for (int r = 0; r < 16; ++r) { o0[r] = 0.f; o1[r] = 0.f; }
    const bf16* Vb = (const bf16*)(ws + WS_PROJ) + OFF_V + kvh * 64 + l31;
#pragma unroll
    for (int kk = 0; kk < 5; ++kk) { const int kt = qt - 4 + kk;
        if (kt >= 0) {
#pragma unroll
            for (int s = 0; s < 2; ++s) { v4u pw;
#pragma unroll
                for (int e = 0; e < 4; ++e) pw[e] = cvtpk(sc[kk][8 * s + 2 * e], sc[kk][8 * s + 2 * e + 1]);
                const bf16x8 pb = __builtin_bit_cast(bf16x8, pw);
                v4u v0, v1;
#pragma unroll
                for (int e = 0; e < 4; ++e) { const int k0 = 32 * kt + 16 * s + 8 * ((2 * e) >> 2) + 4 * hl + ((2 * e) & 3), k1 = k0 + 1;
                    const bf16* r0 = Vb + (size_t)k0 * INP; const bf16* r1 = Vb + (size_t)k1 * INP;
                    v0[e] = (unsigned)r0[0] | ((unsigned)r1[0] << 16); v1[e] = (unsigned)r0[32] | ((unsigned)r1[32] << 16); }
                o0 = MFMA32(__builtin_bit_cast(bf16x8, v0), pb, o0); o1 = MFMA32(__builtin_bit_cast(bf16x8, v1), pb, o1); } } }
    const float inv = 1.0f / l;
    bf16* mix = (bf16*)(ws + WS_XB) + (size_t)qpos * DM + h * 64 + 4 * hl;
#pragma unroll
    for (int g = 0; g < 4; ++g) { v2u w0, w1; w0.x = cvtpk(o0[4 * g] * inv, o0[4 * g + 1] * inv); w0.y = cvtpk(o0[4 * g + 2] * inv, o0[4 * g + 3] * inv);
        w1.x = cvtpk(o1[4 * g] * inv, o1[4 * g + 1] * inv); w1.y = cvtpk(o1[4 * g + 2] * inv, o1[4 * g + 3] * inv);
        *(v2u*)(mix + 8 * g) = w0; *(v2u*)(mix + 32 + 8 * g) = w1; }
}

DI void p4_sattn(const Args& A, int item, int lane) {
    unsigned char* ws = A.ws;
    const int n = item >> 3, kvh = item & 7;
    const float* ck = A.in[I_CK] + (size_t)n * 128 * 512 + kvh * 64; const float* cv = A.in[I_CV] + (size_t)n * 128 * 512 + kvh * 64;
    float* ok = A.out + O_SK + (size_t)n * 128 * 512 + kvh * 64; float* ov = A.out + O_SV + (size_t)n * 128 * 512 + kvh * 64;
    const float* qs = (const float*)(ws + WS_SQA) + (size_t)n * 2048 + kvh * 256 + lane;
    float qv[4];
#pragma unroll
    for (int hq = 0; hq < 4; ++hq) qv[hq] = qs[hq * 64];
    float sc[4][2];
#pragma unroll
    for (int half = 0; half < 2; ++half) { const int idx = lane + 64 * half;
        const f32x4* src = (const f32x4*)(idx < 127 ? ck + (size_t)(idx + 1) * 512 : ok + (size_t)127 * 512);
        f32x4 kr[16];
#pragma unroll
        for (int c = 0; c < 16; ++c) kr[c] = __builtin_nontemporal_load(src + c);
        if (idx < 127) { f32x4* dst = (f32x4*)(ok + (size_t)idx * 512);
#pragma unroll
            for (int c = 0; c < 16; ++c) __builtin_nontemporal_store(kr[c], dst + c); }
        float s0 = 0.f, s1 = 0.f, s2 = 0.f, s3 = 0.f;
#pragma unroll
        for (int d = 0; d < 64; ++d) { const float kd = kr[d >> 2][d & 3]; s0 += kd * rdlane(qv[0], d); s1 += kd * rdlane(qv[1], d); s2 += kd * rdlane(qv[2], d); s3 += kd * rdlane(qv[3], d); }
        sc[0][half] = s0; sc[1][half] = s1; sc[2][half] = s2; sc[3][half] = s3; }
#pragma unroll
    for (int hq = 0; hq < 4; ++hq) { const float sink2 = A.in[I_SINKS][4 * kvh + hq] * LOG2E;
        const float m = fmaxf(wave_max(fmaxf(sc[hq][0], sc[hq][1])), sink2);
        const float p0 = __builtin_amdgcn_exp2f(sc[hq][0] - m), p1 = __builtin_amdgcn_exp2f(sc[hq][1] - m);
        const float l = wave_sum(p0 + p1) + __builtin_amdgcn_exp2f(sink2 - m); const float inv = 1.0f / l;
        sc[hq][0] = p0 * inv; sc[hq][1] = p1 * inv; }
    float o[4] = {0.f, 0.f, 0.f, 0.f};
#pragma unroll
    for (int jb = 0; jb < 8; ++jb) {
        float vv[16];
#pragma unroll
        for (int e = 0; e < 16; ++e) { const int j = 16 * jb + e; vv[e] = j < 127 ? __builtin_nontemporal_load(cv + (size_t)(j + 1) * 512 + lane) : ov[(size_t)127 * 512 + lane]; }
#pragma unroll
        for (int e = 0; e < 16; ++e) { const int j = 16 * jb + e; if (j < 127) __builtin_nontemporal_store(vv[e], ov + (size_t)j * 512 + lane); }
#pragma unroll
        for (int e = 0; e < 16; ++e) { const int j = 16 * jb + e;
#pragma unroll
            for (int hq = 0; hq < 4; ++hq) o[hq] += rdlane(sc[hq][j >> 6], j & 63) * vv[e]; } }
    bf16* mix = (bf16*)(ws + WS_XB) + (size_t)(TP + n) * DM + kvh * 256 + lane;
#pragma unroll
    for (int hq = 0; hq < 4; ++hq) mix[hq * 64] = (bf16)f2bf(o[hq]);
}

DI void p4_sdn_pair(const Args& A, int pairIdx, LAS unsigned char* lds, int tid, int lane) {
    unsigned char* ws = A.ws;
    const int half = tid >> 8, t = tid & 255, w4 = t >> 6;
    const int item = 2 * pairIdx + half, n = item >> 4, hh = item & 15;
    LAS float* KV = (LAS float*)(lds + half * 8192);
    LAS float* RED = KV + 384; LAS float* RED2 = KV + 896;
    if (t < 128) { const size_t go = (size_t)n * 2048 + hh * 128 + t;
        KV[t] = ((const float*)(ws + WS_SKD))[go]; KV[128 + t] = ((const float*)(ws + WS_SQD))[go]; KV[256 + t] = ((const float*)(ws + WS_SVD))[go]; }
    const float* gbs = (const float*)(ws + WS_GBS) + (size_t)n * 32; const float eg = __expf(gbs[hh]), be = gbs[16 + hh];
    const size_t so = ((size_t)(n * 16 + hh) * 128 + 32 * w4) * 128 + 2 * lane;
    const float* Sg = A.in[I_SDELTA] + so; float* So = A.out + O_SD + so;
    f32x2 s[32];
#pragma unroll
    for (int i = 0; i < 32; ++i) s[i] = __builtin_nontemporal_load((const f32x2*)(Sg + i * 128));
    __syncthreads();
    f32x2 r = {0.f, 0.f};
#pragma unroll
    for (int i = 0; i < 32; ++i) r += s[i] * KV[32 * w4 + i];
    *(LAS f32x2*)(RED + w4 * 128 + 2 * lane) = r;
    __syncthreads();
    const f32x2 rt = *(const LAS f32x2*)(RED + 2 * lane) + *(const LAS f32x2*)(RED + 128 + 2 * lane) + *(const LAS f32x2*)(RED + 256 + 2 * lane) + *(const LAS f32x2*)(RED + 384 + 2 * lane);
    const f32x2 u = (*(const LAS f32x2*)(KV + 256 + 2 * lane) - rt * eg) * be;
    f32x2 o = {0.f, 0.f};
#pragma unroll
    for (int i = 0; i < 32; ++i) { const float kk = KV[32 * w4 + i], qq = KV[128 + 32 * w4 + i]; const f32x2 sn = s[i] * eg + u * kk; __builtin_nontemporal_store(sn, (f32x2*)(So + i * 128)); o += sn * qq; }
    *(LAS f32x2*)(RED2 + w4 * 128 + 2 * lane) = o;
    __syncthreads();
    if (w4 == 0) {
        const f32x2 ot = *(const LAS f32x2*)(RED2 + 2 * lane) + *(const LAS f32x2*)(RED2 + 128 + 2 * lane) + *(const LAS f32x2*)(RED2 + 256 + 2 * lane) + *(const LAS f32x2*)(RED2 + 384 + 2 * lane);
        const float ss = wave_sum(ot.x * ot.x + ot.y * ot.y); const float rn = 1.0f / sqrtf(ss * (1.0f / 128.0f) + RMS_EPS);
        const unsigned zz = *(const unsigned*)((const bf16*)(ws + WS_PROJ) + (size_t)(TP + n) * INP + OFF_Z + hh * 128 + 2 * lane);
        const f32x2 nw = *(const f32x2*)(A.in[I_NORMW] + 2 * lane);
        const float y0 = ot.x * rn * nw.x * silu_acc(bflo(zz)), y1 = ot.y * rn * nw.y * silu_acc(bfhi(zz));
        *(unsigned*)((bf16*)(ws + WS_XB) + (size_t)(TP + n) * DM + 2048 + hh * 128 + 2 * lane) = cvtpk(y0, y1);
    }
    __syncthreads();
}

DI void p5_item(const Args& A, int it, LAS unsigned char* lds, int wave, int lane) {
    unsigned char* ws = A.ws;
    const int hh = it >> 7, ck = it & 127, q = lane >> 4, cc = lane & 15, col = 16 * wave + cc;
    const bf16* ST = (const bf16*)(ws + WS_ST) + ((size_t)it * 128 + col) * 128 + 8 * q; const bf16* UT = (const bf16*)(ws + WS_UNT) + ((size_t)it * 128 + col) * 64 + 8 * q;
    const bf16* qd = (const bf16*)(ws + WS_CQD) + (size_t)it * 8192 + cc * 128 + 8 * q; const bf16* at = (const bf16*)(ws + WS_CAT) + (size_t)it * 4096 + cc * 64 + 8 * q;
    const bf16* z = (const bf16*)(ws + WS_PROJ) + (size_t)(ck * 64) * INP + OFF_Z + hh * 128 + col; bf16* mix = (bf16*)(ws + WS_XB) + (size_t)(ck * 64) * DM + 2048 + hh * 128 + col;
    bf16x8 Sb[4], Ub[2], qf[4][4], af[4][2]; unsigned short zz[4][4];
#pragma unroll
    for (int s = 0; s < 4; ++s) Sb[s] = *(const bf16x8*)(ST + 32 * s);
    Ub[0] = *(const bf16x8*)UT; Ub[1] = *(const bf16x8*)(UT + 32);
#pragma unroll
    for (int mt = 0; mt < 4; ++mt) {
#pragma unroll
        for (int s = 0; s < 4; ++s) qf[mt][s] = *(const bf16x8*)(qd + mt * 2048 + 32 * s);
#pragma unroll
        for (int s = 0; s < 2; ++s) if (s <= (mt >> 1)) af[mt][s] = *(const bf16x8*)(at + mt * 1024 + 32 * s); }
#pragma unroll
    for (int mt = 0; mt < 4; ++mt)
#pragma unroll
        for (int r = 0; r < 4; ++r) zz[mt][r] = z[(size_t)(16 * mt + 4 * q + r) * INP];
    const float nw = A.in[I_NORMW][col];
    __builtin_amdgcn_sched_barrier(0);
    f32x4 O[4];
#pragma unroll
    for (int mt = 0; mt < 4; ++mt) { O[mt] = (f32x4){0.f, 0.f, 0.f, 0.f};
#pragma unroll
        for (int s = 0; s < 4; ++s) O[mt] = MFMA16(qf[mt][s], Sb[s], O[mt]);
#pragma unroll
        for (int s = 0; s < 2; ++s) if (s <= (mt >> 1)) O[mt] = MFMA16(af[mt][s], Ub[s], O[mt]); }
    LAS float* SSQ = (LAS float*)lds;
#pragma unroll
    for (int mt = 0; mt < 4; ++mt)
#pragma unroll
        for (int r = 0; r < 4; ++r) { const float ss = row16_sum(O[mt][r] * O[mt][r]); if (cc == 0) SSQ[(16 * mt + 4 * q + r) * 8 + wave] = ss; }
    __syncthreads();
#pragma unroll
    for (int mt = 0; mt < 4; ++mt)
#pragma unroll
        for (int r = 0; r < 4; ++r) { const int t = 16 * mt + 4 * q + r; const f32x4 a = *(const LAS f32x4*)(SSQ + t * 8), b = *(const LAS f32x4*)(SSQ + t * 8 + 4);
            const float ss = ((a[0] + a[1]) + (a[2] + a[3])) + ((b[0] + b[1]) + (b[2] + b[3])); const float rn = 1.0f / sqrtf(ss * (1.0f / 128.0f) + RMS_EPS);
            mix[(size_t)t * DM] = (bf16)f2bf(O[mt][r] * rn * nw * silu_acc(bf2f(zz[mt][r]))); }
    __syncthreads();
}

DI void ln_row(const float* src, int nslab, const float* g, const float* b, float* dstf, bf16* dstb, int lane) {
    const f32x4* xr = (const f32x4*)src + lane;
    f32x4 v[16]; float s = 0.f;
#pragma unroll
    for (int j = 0; j < 16; ++j) v[j] = xr[64 * j];

    for (int k = 1; k < nslab; ++k) { const f32x4* xk = xr + (size_t)k * (128 * DM / 4);
#pragma unroll
        for (int j = 0; j < 16; ++j) v[j] += xk[64 * j]; }
#pragma unroll
    for (int j = 0; j < 16; ++j) s += (v[j][0] + v[j][1]) + (v[j][2] + v[j][3]);
    const float mean = wave_sum(s) * (1.0f / DM); float s2 = 0.f;
#pragma unroll
    for (int j = 0; j < 16; ++j) { v[j] = v[j] - mean; s2 += (v[j][0] * v[j][0] + v[j][1] * v[j][1]) + (v[j][2] * v[j][2] + v[j][3] * v[j][3]); }
    const float rstd = 1.0f / sqrtf(wave_sum(s2) * (1.0f / DM) + LN_EPS);
    const f32x4* g4 = (const f32x4*)g + lane; const f32x4* b4 = (const f32x4*)b + lane;
#pragma unroll
    for (int j = 0; j < 16; ++j) { const f32x4 y = v[j] * rstd * g4[64 * j] + b4[64 * j];
        if (dstf) __builtin_nontemporal_store(y, (f32x4*)dstf + lane + 64 * j);
        if (dstb) { v2u w; w.x = cvtpk(y[0], y[1]); w.y = cvtpk(y[2], y[3]); ((v2u*)dstb + lane)[64 * j] = w; } }
}

DI void ln_row_wg(const float* src, int nslab, const float* g, const float* b, float* dstf, bf16* dstb, LAS unsigned char* lds, int tid, int wave, int lane) {
    LAS float* RED = (LAS float*)lds;
    const f32x4* xr = (const f32x4*)src + 2 * tid;
    f32x4 v0 = xr[0], v1 = xr[1];
#pragma unroll 4
    for (int k = 1; k < nslab; ++k) { const f32x4* xk = xr + (size_t)k * (128 * DM / 4); v0 += xk[0]; v1 += xk[1]; }
    float s = wave_sum((v0[0] + v0[1]) + (v0[2] + v0[3]) + (v1[0] + v1[1]) + (v1[2] + v1[3]));
    if (lane == 0) RED[wave] = s;
    __syncthreads();
    const float mean = (((RED[0] + RED[1]) + (RED[2] + RED[3])) + ((RED[4] + RED[5]) + (RED[6] + RED[7]))) * (1.0f / DM);
    v0 = v0 - mean; v1 = v1 - mean;
    float s2 = wave_sum((v0[0] * v0[0] + v0[1] * v0[1]) + (v0[2] * v0[2] + v0[3] * v0[3]) + (v1[0] * v1[0] + v1[1] * v1[1]) + (v1[2] * v1[2] + v1[3] * v1[3]));
    if (lane == 0) RED[8 + wave] = s2;
    __syncthreads();
    const float rstd = 1.0f / sqrtf((((RED[8] + RED[9]) + (RED[10] + RED[11])) + ((RED[12] + RED[13]) + (RED[14] + RED[15]))) * (1.0f / DM) + LN_EPS);
    const f32x4* g4 = (const f32x4*)g + 2 * tid; const f32x4* b4 = (const f32x4*)b + 2 * tid;
    const f32x4 y0 = v0 * rstd * g4[0] + b4[0], y1 = v1 * rstd * g4[1] + b4[1];
    if (dstf) { ((f32x4*)dstf)[2 * tid] = y0; ((f32x4*)dstf)[2 * tid + 1] = y1; }
    if (dstb) { v4u w; w.x = cvtpk(y0[0], y0[1]); w.y = cvtpk(y0[2], y0[3]); w.z = cvtpk(y1[0], y1[1]); w.w = cvtpk(y1[2], y1[3]); ((v4u*)dstb)[tid] = w; }
    __syncthreads();
}

DI void ln_row_b(const bf16* src, const float* g, const float* b, float* dstf, bf16* dstb, int lane) {
    const v2u* xr = (const v2u*)src + lane;
    f32x4 v[16]; float s = 0.f;
#pragma unroll
    for (int j = 0; j < 16; ++j) { const v2u w = xr[64 * j]; v[j] = (f32x4){bflo(w.x), bfhi(w.x), bflo(w.y), bfhi(w.y)}; s += (v[j][0] + v[j][1]) + (v[j][2] + v[j][3]); }
    const float mean = wave_sum(s) * (1.0f / DM); float s2 = 0.f;
#pragma unroll
    for (int j = 0; j < 16; ++j) { v[j] = v[j] - mean; s2 += (v[j][0] * v[j][0] + v[j][1] * v[j][1]) + (v[j][2] * v[j][2] + v[j][3] * v[j][3]); }
    const float rstd = 1.0f / sqrtf(wave_sum(s2) * (1.0f / DM) + LN_EPS);
    const f32x4* g4 = (const f32x4*)g + lane; const f32x4* b4 = (const f32x4*)b + lane;
#pragma unroll
    for (int j = 0; j < 16; ++j) { const f32x4 y = v[j] * rstd * g4[64 * j] + b4[64 * j];
        if (dstf) __builtin_nontemporal_store(y, (f32x4*)dstf + lane + 64 * j);
        if (dstb) { v2u w; w.x = cvtpk(y[0], y[1]); w.y = cvtpk(y[2], y[3]); ((v2u*)dstb + lane)[64 * j] = w; } }
}

constexpr int N_PHASES = 11;
constexpr int KSPLIT = 16;
constexpr int NSCAN = 16 * 8 / SCAN_NCW;

__global__ void __launch_bounds__(NTHR, 2) fwd(Args args) {
    extern __shared__ __attribute__((aligned(16))) unsigned char lds_raw[];
    LAS unsigned char* lds = (LAS unsigned char*)lds_raw;
    volatile LAS unsigned* MISC = (volatile LAS unsigned*)(lds + MISC_OFF);
    const int tid = threadIdx.x, lane = tid & 63, wave = __builtin_amdgcn_readfirstlane(tid >> 6);
    const int G = gridDim.x, bx = blockIdx.x, gw = bx * NWAVES + wave, NGW = G * NWAVES;
    unsigned char* ws = args.ws;
    gu32* ctl = (gu32*)(ws + WS_CTL);
    for (int u = tid; u < (LDS_BYTES - LDSCTL_OFF) / 4; u += NTHR) ((LAS unsigned*)(lds + LDSCTL_OFF))[u] = 0u;
    __syncthreads();
    const XcdBarrier bar = xcd_barrier_post((unsigned*)(ctl + CW_BAR) + args.li * XCD_BAR_WORDS, MISC + 8);
#define GRID_BAR() xcd_barrier(bar)
    const int lo = args.ph_lo, hi = args.ph_hi;
#define IN(k) (lo <= (k) && (k) < hi)
#define BOTH(k) (IN(k) && IN((k) + 1))

    if (IN(0)) { p0_prologue(args, lds, gw, NGW, wave, lane); if (BOTH(0)) GRID_BAR(); }

    if (IN(1)) {
        pg8::Gemm g{(const pg8::bf16_t*)(ws + WS_XB), (const pg8::bf16_t*)(ws + WS_WIN), MPAD, INP, DM}; pg8::StaticOrder S; S.init(MPAD, INP, DM, G, bx);
        pg8::EpiProj E{(pg8::bf16_t*)(ws + WS_PROJ), INP, (const float*)(ws + WS_BIASP), (float*)(ws + WS_AB), OFF_AB / 256};
        pg8::gemm_phase<pg8::EpiProj, pg8::StaticOrder, true, true>(lds + RING_OFF, g, S, E);
        __syncthreads();
        cv_pull3(args, lds, ctl + CW_QCV + 64 * args.li, 0, CV_T_OUT, wave, lane);
        if (BOTH(1)) GRID_BAR();
    }

    if (IN(3)) {
        for (int it = 2 * bx; it < NITEM; it += 2 * G) p3_pair(args, it, lds, tid, wave, lane);
        for (int it = gw; it < MROWS + 128 * 12; it += NGW) {
            if (it < MROWS) p2_token(args, it, lane);
            else { const int j = it - MROWS; p2_convs(args, j / 12, j % 12, lane); } }
        if (BOTH(3)) GRID_BAR();
    }

    if (IN(4)) {
        const int msk = args.pad;
        if (bx < NSCAN) { if (msk & 1) p4_scan_wg(args, (NSCAN % 8 == 0) ? (bx % 8) * (NSCAN / 8) + bx / 8 : bx, lds, wave, lane); }
        else {
            const int ob = bx - NSCAN, NOB = G - NSCAN;
            if (NOB == 192) {
                const bool grpA = ob < 128;
                if (msk & 2) { for (int k = 0; k < 5; ++k) p4_sdn_pair(args, ob + 192 * k, lds, tid, lane); if (!grpA) p4_sdn_pair(args, 960 + (ob - 128), lds, tid, lane); }
                if (grpA) { if (msk & 4) p4_sattn(args, ob * NWAVES + wave, lane);
                    if (msk & 8) for (int k = 0; k < 4; ++k) p4_attn(args, ob * NWAVES + wave + 1024 * k, lane); }
                else { if (msk & 8) for (int k = 0; k < 8; ++k) p4_attn(args, 4096 + (ob - 128) * NWAVES + wave + 512 * k, lane); }
            } else {
                if (msk & 2) for (int p = ob; p < 1024; p += NOB) p4_sdn_pair(args, p, lds, tid, lane);
                if (msk & 4) for (int it = ob * NWAVES + wave; it < 1024; it += NOB * NWAVES) p4_sattn(args, it, lane);
                if (msk & 8) for (int it = ob * NWAVES + wave; it < 256 * 32; it += NOB * NWAVES) p4_attn(args, it, lane);
            }
        }
        if (BOTH(4)) GRID_BAR();
    }

    if (IN(5)) {
        for (int it = bx; it < NITEM; it += G) p5_item(args, it, lds, wave, lane);
        if (BOTH(5)) GRID_BAR();
    }

    if (IN(6)) {
        pg8::Gemm g{(const pg8::bf16_t*)(ws + WS_XB), (const pg8::bf16_t*)(ws + WS_WOUT), MPAD, DM, DM}; pg8::SplitTailOrder S; S.init(TP, DM, DM, (args.pad & 128) ? -1 : KSPLIT, G, bx);
        float* t1 = (float*)(ws + WS_PROJ);
        pg8::EpiRes E{args.in[I_XP], args.in[I_XS], t1, (float*)(ws + WS_SLAB), TP, MROWS, DM, TP / 256, ALPHA, nullptr, (pg8::bf16_t*)(ws + WS_PROJ)};
        pg8::gemm_phase<pg8::EpiRes, pg8::SplitTailOrder, true, true>(lds + RING_OFF, g, S, E);
        if (BOTH(6)) GRID_BAR();
    }

    if (IN(7)) {
        float* t1 = (float*)(ws + WS_PROJ);
        for (int r = TP + bx; r < MROWS; r += G) ln_row_wg((const float*)(ws + WS_SLAB) + (size_t)(r - TP) * DM, KSPLIT, args.in[I_LN1G], args.in[I_LN1B], nullptr, (bf16*)(ws + WS_XB) + (size_t)r * DM, lds, tid, wave, lane);
        for (int r = gw; r < TP; r += NGW) ln_row_b((const bf16*)(ws + WS_PROJ) + (size_t)r * DM, args.in[I_LN1G], args.in[I_LN1B], nullptr, (bf16*)(ws + WS_XB) + (size_t)r * DM, lane);
        if (BOTH(7)) GRID_BAR();
    }

    if (IN(8)) {
        pg8::Gemm g{(const pg8::bf16_t*)(ws + WS_XB), (const pg8::bf16_t*)(ws + WS_WGU), MPAD, NGU, DM}; pg8::StaticOrder S; S.init(MPAD, NGU, DM, G, bx);
        pg8::EpiSwiGLU E{(pg8::bf16_t*)(ws + WS_FFN), FF};
        pg8::gemm_phase<pg8::EpiSwiGLU, pg8::StaticOrder, true, true>(lds + RING_OFF, g, S, E);
        __syncthreads();
        cv_pull3(args, lds, ctl + CW_QCV + 256 + 64 * args.li, CV_T_OUT, CV_T3, wave, lane);
        if (BOTH(8)) GRID_BAR();
    }

    if (IN(9)) {
        pg8::Gemm g{(const pg8::bf16_t*)(ws + WS_FFN), (const pg8::bf16_t*)(ws + WS_WDN), MPAD, DM, FF}; pg8::SplitTailOrder S; S.init(TP, DM, FF, KSPLIT, G, bx);
        const float* h = (const float*)(ws + WS_PROJ);
        pg8::EpiRes E{h, h + (size_t)TP * DM, args.out + O_Y, (float*)(ws + WS_SLAB), TP, MROWS, DM, TP / 256, ALPHA, (const pg8::bf16_t*)(ws + WS_XB), (pg8::bf16_t*)(ws + WS_T2B)};
        pg8::gemm_phase<pg8::EpiRes, pg8::SplitTailOrder, true, true>(lds + RING_OFF, g, S, E);
        if (BOTH(9)) GRID_BAR();
    }

    if (IN(10)) {
        float* y = args.out + O_Y;
        for (int r = TP + bx; r < MROWS; r += G) ln_row_wg((const float*)(ws + WS_SLAB) + (size_t)(r - TP) * DM, KSPLIT, args.in[I_LN2G], args.in[I_LN2B], y + (size_t)r * DM, nullptr, lds, tid, wave, lane);
        for (int r = gw; r < TP; r += NGW) ln_row_b((const bf16*)(ws + WS_T2B) + (size_t)r * DM, args.in[I_LN2G], args.in[I_LN2B], y + (size_t)r * DM, nullptr, lane);
    }
#undef IN
#undef BOTH
#undef GRID_BAR
}

extern "C" void kernel_launch(void* const* d_in, const int* in_sizes, int n_in, void* d_out, int out_size, void* d_ws, size_t ws_size, hipStream_t stream) {
    static int grid = 0;
    if (grid == 0) {
        if (n_in != 21 || (size_t)out_size != O_END || ws_size < WS_END) { fprintf(stderr, "kernel_launch: unexpected problem (n_in %d, out %d, ws %zu); nothing launched\n", n_in, out_size, ws_size); grid = -1; return; }
        int dev = 0, cus = 0, per_cu = 0;
        if (hipGetDevice(&dev) != hipSuccess || hipDeviceGetAttribute(&cus, hipDeviceAttributeMultiprocessorCount, dev) != hipSuccess) { grid = -1; return; }
        if (hipFuncSetAttribute((const void*)fwd, hipFuncAttributeMaxDynamicSharedMemorySize, LDS_BYTES) != hipSuccess) { fprintf(stderr, "kernel_launch: hipFuncSetAttribute failed\n"); grid = -1; return; }
        if (hipOccupancyMaxActiveBlocksPerMultiprocessor(&per_cu, (const void*)fwd, NTHR, LDS_BYTES) != hipSuccess || per_cu < 1) { fprintf(stderr, "kernel_launch: occupancy query reports %d workgroups per CU\n", per_cu); }
        (void)hipGetLastError();
        grid = cus;
        if (grid < 2 * NSCAN) { fprintf(stderr, "kernel_launch: needs >= %d CUs, device has %d\n", 2 * NSCAN, cus); grid = -1; return; }
    }
    if (grid < 0) return;
    if (hipMemsetAsync((char*)d_ws + WS_CTL, 0, CTL_ZERO_BYTES, stream) != hipSuccess) return;
    Args a{};
    for (int i = 0; i < 21; ++i) a.in[i] = (const float*)d_in[i];
    a.out = (float*)d_out; a.ws = (unsigned char*)d_ws;
#if defined(PROBE_PHASE)
    const int nl = 3, los[3] = {0, PROBE_PHASE, PROBE_PHASE + 1}, his[3] = {PROBE_PHASE + 1, PROBE_PHASE + 1, N_PHASES};
#else
    const int nl = 1, los[1] = {0}, his[1] = {N_PHASES};
#endif
    for (int li = 0; li < nl; ++li) {
        if (los[li] >= his[li]) continue;
        a.ph_lo = los[li]; a.ph_hi = his[li]; a.li = li; a.pad = 15;
#if defined(PROBE_MASK)
        if (li == 1) a.pad = PROBE_MASK;
#endif
        hipLaunchKernelGGL(fwd, dim3(grid), dim3(NTHR), LDS_BYTES, stream, a);
        const hipError_t le = hipPeekAtLastError();
        if (le != hipSuccess) { fprintf(stderr, "kernel_launch: launch %d failed: %s\n", li, hipGetErrorName(le)); break; }
    }
}
```

```cpp
#include <hip/hip_runtime.h>
#include <cstdio>
#include <cstdint>
#include <cmath>
namespace pg8 {
#define PG8_LAS __attribute__((address_space(3)))
typedef unsigned short bf16_t;
typedef short bf16x8 __attribute__((ext_vector_type(8)));
typedef float f32x4 __attribute__((ext_vector_type(4)));
typedef unsigned u32x4 __attribute__((ext_vector_type(4)));
constexpr int BM = 256, BK = 64, HALF = 128, HTB = HALF * BK * 2  , STAGE_BYTES = 8 * HTB, NXCD = 8, WGM = 8;

__host__ __device__ __forceinline__ int lds_byte(int r, int c) { const int st = (r >> 4) * 2 + (c >> 5), rr = r & 15, cc = c & 31, ob = rr * 64 + cc * 2; return st * 1024 + (ob ^ (((ob >> 9) & 1) << 5)); }
__host__ __device__ __forceinline__ void stage_rc(int b, int& R, int& C) { const int st = b / 1024, sb = b % 1024, swz = sb ^ (((sb >> 9) & 1) << 5); R = (st >> 1) * 16 + swz / 64; C = (st & 1) * 32 + (swz % 64) / 2; }
__host__ __device__ __forceinline__ int perm32(int rho) { const int n = rho >> 4, i = rho & 15; return 8 * (i >> 2) + 4 * n + (i & 3); }

struct Unit { int pm, pn, k0, nt, ks; };
struct Gemm { const bf16_t* A; const bf16_t* Bt; int M, N, K; };

struct StaticOrder {
    int nM, nN, nwg, G, c, ntf;
    __host__ __device__ void init(int M, int N, int K, int G_, int c_) { nM = M / BM; nN = N / BM; nwg = nM * nN; G = G_; c = c_; ntf = K / BK; }
    __host__ __device__ __forceinline__ bool next(int i, Unit& u) const {
        const long L = (long)i * G + c; if (L >= nwg) return false;
        int wgid = (int)L; { const int q = nwg / NXCD, r = nwg % NXCD, xcd = wgid % NXCD, off = wgid / NXCD; wgid = (xcd < r ? xcd * (q + 1) : r * (q + 1) + (xcd - r) * q) + off; }
        const int nig = WGM * nN, gid = wgid / nig, fm = gid * WGM, gsz = (nM - fm) < WGM ? (nM - fm) : WGM;
        u.pm = fm + ((wgid % nig) % gsz); u.pn = (wgid % nig) / gsz; u.k0 = 0; u.nt = ntf; u.ks = 0; return true;
    }
    __device__ __forceinline__ void a_ready(const Unit&) const {}
    __device__ __forceinline__ void done(const Unit&) const {}
};

struct SplitTailOrder {
    int nMf, nN, nwg, G, c, ntf, S, base, rem;
    __host__ __device__ __forceinline__ void init(int Mfull, int N, int K, int S_, int G_, int c_) { nMf = Mfull / BM; nN = N / BM; nwg = nMf * nN; G = G_; c = c_; ntf = K / BK; S = S_; base = (K / (2 * BK)) / (S_ > 0 ? S_ : 1); rem = (K / (2 * BK)) % (S_ > 0 ? S_ : 1); }
    __host__ __device__ __forceinline__ bool next(int i, Unit& u) const {
        const int L = i * G + c; if (L >= nwg + nN * S) return false;
        const bool fu = L < nwg;
#if defined(PROBE_MASK)
        if (!fu && S < 0) return false;
#endif
        int wgid = fu ? L : 0; { const int q = nwg / NXCD, r = nwg % NXCD, xcd = wgid % NXCD, off = wgid / NXCD; wgid = (xcd < r ? xcd * (q + 1) : r * (q + 1) + (xcd - r) * q) + off; }
        const int nig = WGM * nN, gid = wgid / nig, fm = gid * WGM, gsz = (nMf - fm) < WGM ? (nMf - fm) : WGM;
        const int j = fu ? 0 : L - nwg, ks = j % S;
        u.pm = fu ? fm + ((wgid % nig) % gsz) : nMf; u.pn = fu ? (wgid % nig) / gsz : j / S; u.ks = ks;
        u.nt = fu ? ntf : 2 * (base + (ks < rem ? 1 : 0)); u.k0 = fu ? 0 : 2 * BK * (ks * base + (ks < rem ? ks : rem)); return true;
    }
    __device__ __forceinline__ void a_ready(const Unit&) const {}
    __device__ __forceinline__ void done(const Unit&) const {}
};

__device__ __forceinline__ unsigned cvt_pk_bf16(float lo, float hi) { unsigned r; asm volatile("v_cvt_pk_bf16_f32 %0, %1, %2" : "=v"(r) : "v"(lo), "v"(hi)); return r; }
typedef float f32x2 __attribute__((ext_vector_type(2)));

struct EpiProj {
    static constexpr bool PERM = true, AFTER_DRAIN = false;
    bf16_t* O; int ldc; const float* bias; float* ab; int ab_pn;
    __device__ __forceinline__ void operator()(const f32x4 (&acc)[2][2][4][2], const Unit& u, int wr, int wc, int fr, int fq) const {
        const int row0 = u.pm * BM + wr * 64 + fr; const int col0 = u.pn * BM + wc * 32 + 8 * fq;
        f32x4 bv[2][2];
#pragma unroll
        for (int bj = 0; bj < 2; ++bj)
#pragma unroll
            for (int n = 0; n < 2; ++n) bv[bj][n] = *(const f32x4*)(bias + col0 + bj * HALF + 4 * n);
        const bool do_ab = (u.pn == ab_pn) && (wc == 0);
#pragma unroll
        for (int ai = 0; ai < 2; ++ai)
#pragma unroll
            for (int m = 0; m < 4; ++m) { const int row = row0 + ai * HALF + m * 16; bf16_t* rowp = O + (size_t)row * ldc + col0;
#pragma unroll
                for (int bj = 0; bj < 2; ++bj) { const f32x4 v0 = acc[ai][bj][m][0] + bv[bj][0], v1 = acc[ai][bj][m][1] + bv[bj][1];
                    u32x4 w; w.x = cvt_pk_bf16(v0[0], v0[1]); w.y = cvt_pk_bf16(v0[2], v0[3]); w.z = cvt_pk_bf16(v1[0], v1[1]); w.w = cvt_pk_bf16(v1[2], v1[3]);
                    *(u32x4*)(rowp + bj * HALF) = w;
                    if (bj == 0 && do_ab) { float* ap = ab + (size_t)row * 32 + 8 * fq; *(f32x4*)ap = v0; *(f32x4*)(ap + 4) = v1; } } }
    }
};
struct EpiRes {
    static constexpr bool PERM = false, AFTER_DRAIN = false;
    const float* res0; const float* res1; float* out0; float* slab; int split, mrows, ldc, pm_s; float alpha; const bf16_t* resb; bf16_t* outb;
    static __device__ __forceinline__ f32x4 ldb4(const bf16_t* p) { const unsigned long long w = *(const unsigned long long*)p; const unsigned lo = (unsigned)w, hi = (unsigned)(w >> 32);
        return (f32x4){__uint_as_float(lo << 16), __uint_as_float(lo & 0xffff0000u), __uint_as_float(hi << 16), __uint_as_float(hi & 0xffff0000u)}; }
    __device__ __forceinline__ void operator()(const f32x4 (&acc)[2][2][4][2], const Unit& u, int wr, int wc, int fr, int fq) const {
        const int col0 = u.pn * BM + wc * 32 + 4 * fq;
        if (u.pm < pm_s) {
#pragma unroll
            for (int ai = 0; ai < 2; ++ai) {
                f32x4 rv[4][2][2];
#pragma unroll
                for (int m = 0; m < 4; ++m) { const size_t ro = (size_t)(u.pm * BM + ai * HALF + wr * 64 + m * 16 + fr) * ldc + col0;
#pragma unroll
                    for (int bj = 0; bj < 2; ++bj)
#pragma unroll
                        for (int n = 0; n < 2; ++n) rv[m][bj][n] = resb ? ldb4(resb + ro + bj * HALF + n * 16) : *(const f32x4*)(res0 + ro + bj * HALF + n * 16); }
                __builtin_amdgcn_sched_barrier(0);
#pragma unroll
                for (int m = 0; m < 4; ++m) { float* op = out0 + (size_t)(u.pm * BM + ai * HALF + wr * 64 + m * 16 + fr) * ldc + col0;
#pragma unroll
                    for (int bj = 0; bj < 2; ++bj)
#pragma unroll
                        for (int n = 0; n < 2; ++n) { const f32x4 o = rv[m][bj][n] * alpha + acc[ai][bj][m][n];
                            if (outb) { typedef unsigned u32x2 __attribute__((ext_vector_type(2))); u32x2 w; w.x = cvt_pk_bf16(o[0], o[1]); w.y = cvt_pk_bf16(o[2], o[3]); *(u32x2*)(outb + (size_t)(u.pm * BM + ai * HALF + wr * 64 + m * 16 + fr) * ldc + col0 + bj * HALF + n * 16) = w; }
                            else *(f32x4*)(op + bj * HALF + n * 16) = o; } }
            }
        } else {
#pragma unroll
            for (int m = 0; m < 4; ++m) { const int lr = wr * 64 + m * 16 + fr;
                if (lr < mrows - split) { const float* rp = res1 + (size_t)lr * ldc; float* op = slab + ((size_t)u.ks * HALF + lr) * ldc;
#pragma unroll
                    for (int bj = 0; bj < 2; ++bj)
#pragma unroll
                        for (int n = 0; n < 2; ++n) { const int c = col0 + bj * HALF + n * 16; f32x4 o = acc[0][bj][m][n]; if (u.ks == 0) o += (resb ? ldb4(resb + (size_t)(split + lr) * ldc + c) : *(const f32x4*)(rp + c)) * alpha; *(f32x4*)(op + c) = o; } } }
        }
    }
};
struct EpiSwiGLU {
    static constexpr bool PERM = true, AFTER_DRAIN = false;
    bf16_t* O; int ldc;
    static __device__ __forceinline__ float silu_mul(float g, float uu) { return g * uu * __builtin_amdgcn_rcpf(1.0f + __builtin_amdgcn_exp2f(-1.4426950408889634f * g)); }
    __device__ __forceinline__ void operator()(const f32x4 (&acc)[2][2][4][2], const Unit& u, int wr, int wc, int fr, int fq) const {
        const int row0 = u.pm * BM + wr * 64 + fr; const int col0 = u.pn * HALF + wc * 32 + 8 * fq;
#pragma unroll
        for (int ai = 0; ai < 2; ++ai)
#pragma unroll
            for (int m = 0; m < 4; ++m) { bf16_t* rowp = O + (size_t)(row0 + ai * HALF + m * 16) * ldc + col0;
                const f32x4 g0 = acc[ai][0][m][0], g1 = acc[ai][0][m][1], u0 = acc[ai][1][m][0], u1 = acc[ai][1][m][1];
                u32x4 w; w.x = cvt_pk_bf16(silu_mul(g0[0], u0[0]), silu_mul(g0[1], u0[1])); w.y = cvt_pk_bf16(silu_mul(g0[2], u0[2]), silu_mul(g0[3], u0[3]));
                w.z = cvt_pk_bf16(silu_mul(g1[0], u1[0]), silu_mul(g1[1], u1[1])); w.w = cvt_pk_bf16(silu_mul(g1[2], u1[2]), silu_mul(g1[3], u1[3]));
                *(u32x4*)rowp = w; }
    }
};
template <class Epi, class Sched, bool ALIGN_EPI = false, bool SP2 = false>
__device__ __forceinline__ void gemm_phase(PG8_LAS unsigned char* lds, const Gemm g, const Sched& S, const Epi& E) {
    const int tid = threadIdx.x, wid = __builtin_amdgcn_readfirstlane(tid >> 6), lane = tid & 63, wr = wid >> 2, wc = wid & 3, fr = lane & 15, fq = lane >> 4;
    const int K = g.K;
    unsigned voffA[2], voffB[2];
#pragma unroll
    for (int i = 0; i < 2; ++i) { int R, C; stage_rc(tid * 16 + i * 8192, R, C); const int Rb = Epi::PERM ? ((R & ~31) + perm32(R & 31)) : R;
        voffA[i] = (unsigned)(R * K + C) * 2u; voffB[i] = (unsigned)(Rb * K + C) * 2u; }
    const size_t kstep = (size_t)(BK * 2);
    const size_t hstep = (size_t)HALF * K * 2;
    const size_t tstep = 2 * hstep;
    const unsigned ldsw = (unsigned)wid * 1024u;
    const int aoff = lds_byte(wr * 64 + fr, fq * 8), boff = lds_byte(wc * 32 + fr, fq * 8);
#define PG8_SA(b, h) (((b) * 2 + (h)) * HTB)
#define PG8_SB(b, h) ((4 + (b) * 2 + (h)) * HTB)
#define PG8_STAGE(bufoff, gbase, voff) do { _Pragma("unroll") for (int _i = 0; _i < 2; ++_i) \
        __builtin_amdgcn_global_load_lds((const unsigned*)((const char*)(gbase) + (voff)[_i]), (PG8_LAS unsigned*)(lds + (bufoff) + ldsw + _i * 8192), 16, 0, 0); } while (0)
#define PG8_LDA(dst, b, h) do { _Pragma("unroll") for (int m = 0; m < 4; ++m) _Pragma("unroll") for (int k = 0; k < 2; ++k) dst[m][k] = *(const PG8_LAS bf16x8*)(lds + PG8_SA(b, h) + aoff + m * 2048 + k * 1024); } while (0)
#define PG8_LDB(dst, b, h) do { _Pragma("unroll") for (int n = 0; n < 2; ++n) _Pragma("unroll") for (int k = 0; k < 2; ++k) dst[n][k] = *(const PG8_LAS bf16x8*)(lds + PG8_SB(b, h) + boff + n * 2048 + k * 1024); } while (0)
#define PG8_MMA(ai, bj, At, Bt) do { __builtin_amdgcn_s_setprio(1); _Pragma("unroll") for (int m = 0; m < 4; ++m) _Pragma("unroll") for (int n = 0; n < 2; ++n) _Pragma("unroll") for (int k = 0; k < 2; ++k) \
        acc[ai][bj][m][n] = __builtin_amdgcn_mfma_f32_16x16x32_bf16(Bt[n][k], At[m][k], acc[ai][bj][m][n], 0, 0, 0); __builtin_amdgcn_s_setprio(0); } while (0)
#define PG8_WAIT_V(n) asm volatile("s_waitcnt vmcnt(" #n ")" ::: "memory")
#define PG8_WAIT_L(n) asm volatile("s_waitcnt lgkmcnt(" #n ")" ::: "memory")
#define PG8_BAR __builtin_amdgcn_s_barrier()
#define PG8_SCHED __builtin_amdgcn_sched_barrier(0)
    Unit cur, nxt; int ui = 0;
    if (!S.next(0, cur)) return;
    f32x4 acc[2][2][4][2];
#pragma unroll
    for (int a = 0; a < 2; ++a)
#pragma unroll
        for (int b = 0; b < 2; ++b)
#pragma unroll
            for (int m = 0; m < 4; ++m)
#pragma unroll
                for (int n = 0; n < 2; ++n) acc[a][b][m][n] = (f32x4){0.f, 0.f, 0.f, 0.f};
    bf16x8 At[4][2], B0[2][2], B1[2][2];
    const char* cA = (const char*)g.A + (size_t)cur.pm * tstep + (size_t)cur.k0 * 2; const char* cB = (const char*)g.Bt + (size_t)cur.pn * tstep + (size_t)cur.k0 * 2;
    S.a_ready(cur);
    if constexpr (SP2) {
        PG8_STAGE(PG8_SB(0, 0), cB, voffB); PG8_STAGE(PG8_SB(0, 1), cB + hstep, voffB); PG8_STAGE(PG8_SA(0, 0), cA, voffA); PG8_STAGE(PG8_SA(0, 1), cA + hstep, voffA);
        if (wr == 1) PG8_BAR;
        PG8_WAIT_V(2); PG8_BAR;
        PG8_STAGE(PG8_SB(1, 0), cB + kstep, voffB); PG8_STAGE(PG8_SA(1, 0), cA + kstep, voffA); PG8_STAGE(PG8_SB(1, 1), cB + hstep + kstep, voffB);
        PG8_WAIT_V(6); PG8_BAR;
    } else {
        PG8_STAGE(PG8_SB(0, 0), cB, voffB); PG8_STAGE(PG8_SA(0, 0), cA, voffA); PG8_STAGE(PG8_SB(0, 1), cB + hstep, voffB); PG8_STAGE(PG8_SA(0, 1), cA + hstep, voffA);
        if (wr == 1) PG8_BAR;
        PG8_WAIT_V(4); PG8_BAR;
        PG8_STAGE(PG8_SB(1, 0), cB + kstep, voffB); PG8_STAGE(PG8_SA(1, 0), cA + kstep, voffA); PG8_STAGE(PG8_SB(1, 1), cB + hstep + kstep, voffB);
        PG8_WAIT_V(6); PG8_BAR;
    }
    for (;;) {
        const bool has_next = S.next(ui + 1, nxt);
        const char* nA = has_next ? (const char*)g.A + (size_t)nxt.pm * tstep + (size_t)nxt.k0 * 2 : cA; const char* nB = has_next ? (const char*)g.Bt + (size_t)nxt.pn * tstep + (size_t)nxt.k0 * 2 : cB;
        const int nt = cur.nt;
        for (int t = 0; t < nt; t += 2) {
            const bool last = (t == nt - 2);
            const char* a1 = cA + (size_t)(t + 1) * kstep;
            const char* a2 = last ? nA : cA + (size_t)(t + 2) * kstep; const char* b2 = last ? nB : cB + (size_t)(t + 2) * kstep;
            const char* a3 = a2 + kstep; const char* b3 = b2 + kstep;
            if (last && has_next) S.a_ready(nxt);
            if constexpr (SP2) {
            PG8_LDB(B0, 0, 0); PG8_LDB(B1, 0, 1); PG8_SCHED; PG8_LDA(At, 0, 0); PG8_STAGE(PG8_SA(1, 1), a1 + hstep, voffA);
            PG8_WAIT_V(8); PG8_WAIT_L(0); PG8_BAR; PG8_MMA(0, 0, At, B0); PG8_MMA(0, 1, At, B1); PG8_BAR; PG8_SCHED;
            PG8_LDA(At, 0, 1); PG8_STAGE(PG8_SB(0, 0), b2, voffB); PG8_STAGE(PG8_SB(0, 1), b2 + hstep, voffB); PG8_STAGE(PG8_SA(0, 0), a2, voffA);
            PG8_WAIT_V(8); PG8_WAIT_L(0); PG8_BAR; PG8_MMA(1, 0, At, B0); PG8_MMA(1, 1, At, B1); PG8_BAR; PG8_SCHED;
            PG8_LDB(B0, 1, 0); PG8_LDB(B1, 1, 1); PG8_SCHED; PG8_LDA(At, 1, 0); PG8_STAGE(PG8_SA(0, 1), a2 + hstep, voffA);
            PG8_WAIT_V(8); PG8_WAIT_L(0); PG8_BAR; PG8_MMA(0, 0, At, B0); PG8_MMA(0, 1, At, B1); PG8_BAR; PG8_SCHED;
            PG8_LDA(At, 1, 1); PG8_STAGE(PG8_SB(1, 0), b3, voffB); PG8_STAGE(PG8_SB(1, 1), b3 + hstep, voffB); PG8_STAGE(PG8_SA(1, 0), a3, voffA);
            PG8_WAIT_V(8); PG8_WAIT_L(0); PG8_BAR; PG8_MMA(1, 0, At, B0); PG8_MMA(1, 1, At, B1); PG8_BAR; PG8_SCHED;
            } else {
            PG8_LDB(B0, 0, 0); PG8_SCHED; PG8_LDA(At, 0, 0); PG8_STAGE(PG8_SA(1, 1), a1 + hstep, voffA);
            PG8_WAIT_L(8); PG8_BAR; PG8_WAIT_L(0); PG8_MMA(0, 0, At, B0); PG8_BAR; PG8_SCHED;
            PG8_LDB(B1, 0, 1); PG8_STAGE(PG8_SB(0, 0), b2, voffB);
            PG8_BAR; PG8_WAIT_L(0); PG8_MMA(0, 1, At, B1); PG8_BAR;
            PG8_LDA(At, 0, 1); PG8_STAGE(PG8_SA(0, 0), a2, voffA);
            PG8_BAR; PG8_WAIT_L(0); PG8_MMA(1, 0, At, B0); PG8_BAR; PG8_SCHED;
            PG8_STAGE(PG8_SB(0, 1), b2 + hstep, voffB);
            PG8_WAIT_V(6); PG8_BAR; PG8_MMA(1, 1, At, B1); PG8_BAR;
            PG8_LDB(B0, 1, 0); PG8_SCHED; PG8_LDA(At, 1, 0); PG8_STAGE(PG8_SA(0, 1), a2 + hstep, voffA);
            PG8_WAIT_L(8); PG8_BAR; PG8_WAIT_L(0); PG8_MMA(0, 0, At, B0); PG8_BAR; PG8_SCHED;
            PG8_LDB(B1, 1, 1); PG8_STAGE(PG8_SB(1, 0), b3, voffB);
            PG8_BAR; PG8_WAIT_L(0); PG8_MMA(0, 1, At, B1); PG8_BAR;
            PG8_LDA(At, 1, 1); PG8_STAGE(PG8_SA(1, 0), a3, voffA);
            PG8_BAR; PG8_WAIT_L(0); PG8_MMA(1, 0, At, B0); PG8_BAR; PG8_SCHED;
            PG8_STAGE(PG8_SB(1, 1), b3 + hstep, voffB);
            PG8_WAIT_V(6); PG8_BAR; PG8_MMA(1, 1, At, B1); PG8_BAR;
            }
        }
        if constexpr (ALIGN_EPI) { if (wr == 0) PG8_BAR; }
        if constexpr (!Epi::AFTER_DRAIN) { E(acc, cur, wr, wc, fr, fq); S.done(cur); }
        if (!has_next) break;
#pragma unroll
        for (int a = 0; a < 2; ++a)
#pragma unroll
            for (int b = 0; b < 2; ++b)
#pragma unroll
                for (int m = 0; m < 4; ++m)
#pragma unroll
                    for (int n = 0; n < 2; ++n) acc[a][b][m][n] = (f32x4){0.f, 0.f, 0.f, 0.f};
        cur = nxt; cA = nA; cB = nB; ++ui;
        if constexpr (ALIGN_EPI) { if (wr == 1) PG8_BAR; }
    }
    PG8_WAIT_V(0);
    if constexpr (!ALIGN_EPI) { if (wr == 0) PG8_BAR; }
    PG8_BAR;
    if constexpr (Epi::AFTER_DRAIN) { E.fused(acc, cur, wr, wc, fr, fq, lds, wid, lane); S.done(cur); }
#undef PG8_SA
#undef PG8_SB
#undef PG8_STAGE
#undef PG8_LDA
#undef PG8_LDB
#undef PG8_MMA
#undef PG8_WAIT_V
#undef PG8_WAIT_L
#undef PG8_BAR
#undef PG8_SCHED
}
}

constexpr int NWAVES = 8, NTHR = NWAVES * 64;
constexpr int DM = 4096, TP = 8192, NS = 128, MROWS = TP + NS, MPAD = 8448;
constexpr int INW = 11296, INP = 11520;
constexpr int OFF_K = 2048, OFF_V = 2560, OFF_PRE = 3072, OFF_Z = 9216, OFF_AB = 11264;
constexpr int CONVD = 6144, FF = 11008, NGU = 2 * FF;
constexpr int NCHUNK = 128, NITEM = 16 * NCHUNK;
constexpr float ALPHA = 1.189207115002721f;
constexpr float LN_EPS = 1e-5f, RMS_EPS = 1e-6f, LOG2E = 1.4426950408889634f;
constexpr float QSCALE = 0.125f * LOG2E;
constexpr size_t O_Y = 0, O_PK = 34078720, O_PV = 34144256, O_PC = 34209792, O_PD = 34228224, O_SK = 34490368, O_SV = 42878976, O_SC = 51267584, O_SD = 53626880, O_END = 87181312;

constexpr size_t MiB = 1u << 20;
constexpr size_t WS_CTL = 0, CTL_ZERO_BYTES = 1 * MiB;
constexpr size_t WS_BIASP = 1 * MiB;
constexpr size_t WS_ROPE = 2 * MiB;
constexpr size_t WS_AB = 5 * MiB;
constexpr size_t WS_GB = 6 * MiB + 512 * 1024;
constexpr size_t WS_GL = 7 * MiB + 640 * 1024;
constexpr size_t WS_SQA = 8 * MiB, WS_SQD = 9 * MiB, WS_SKD = 10 * MiB, WS_SVD = 11 * MiB;
constexpr size_t WS_WOUT = 12 * MiB, WS_WGU = 44 * MiB, WS_WDN = 216 * MiB, WS_WIN = 302 * MiB;
constexpr size_t WS_QB = 302 * MiB, WS_KB = 334 * MiB;
constexpr size_t WS_XB = 392 * MiB;
constexpr size_t WS_PROJ = 458 * MiB;
constexpr size_t WS_QH = 644 * MiB, WS_KH = 676 * MiB, WS_VH = 708 * MiB;
constexpr size_t WS_ST = 644 * MiB, WS_UNT = 708 * MiB;
constexpr size_t WS_CWN = 740 * MiB, WS_CQD = 772 * MiB, WS_CKD = 804 * MiB, WS_CAT = 836 * MiB, WS_CU = 852 * MiB;
constexpr size_t WS_FFN = 644 * MiB;
constexpr size_t WS_T2B = 526 * MiB;
constexpr size_t WS_SLAB = 916 * MiB;
constexpr size_t WS_END = 948 * MiB;
static_assert(WS_WIN + (size_t)INP * DM * 2 <= WS_XB && WS_XB + (size_t)MPAD * DM * 2 <= WS_PROJ && WS_PROJ + (size_t)MPAD * INP * 2 <= WS_QH && WS_CU + (size_t)NITEM * 64 * 128 * 4 <= WS_END && WS_FFN + (size_t)MPAD * FF * 2 <= WS_END, "ws map");
static_assert(WS_WGU + (size_t)NGU * DM * 2 <= WS_WDN && WS_WDN + (size_t)DM * FF * 2 <= WS_WIN && WS_ROPE + 8193 * 32 * 8 <= WS_AB && WS_AB + (size_t)MPAD * 32 * 4 <= WS_GB && WS_GB + TP * 32 * 4 <= WS_GL, "ws map 2");
constexpr int CW_TMO = 0, CW_CODE = 1, CW_BAR = 4096, CW_QATT = 16384, CW_QSMP = 16384 + 64, CW_QCV = 16384 + 1024, CW_XRANK = 32768;

constexpr int RING_OFF = 0, RING_BYTES = 147456, LDSCTL_OFF = RING_BYTES, MISC_OFF = LDSCTL_OFF + 320, LDS_BYTES = 163840;
#define GAS __attribute__((address_space(1)))
#define LAS __attribute__((address_space(3)))
typedef unsigned short bf16;
typedef unsigned v4u __attribute__((ext_vector_type(4)));
typedef float f32x4 __attribute__((ext_vector_type(4)));
typedef short bf16x8 __attribute__((ext_vector_type(8)));
typedef GAS unsigned gu32;
typedef GAS unsigned long long gu64;
#define RLX_AGENT __ATOMIC_RELAXED, __HIP_MEMORY_SCOPE_AGENT
#define LDS_WAIT() asm volatile("s_waitcnt lgkmcnt(0)" ::: "memory")
#define VM_WAIT() asm volatile("s_waitcnt vmcnt(0)" ::: "memory")
__device__ __forceinline__ unsigned long long rt() { return __builtin_amdgcn_s_memrealtime(); }
__device__ __forceinline__ unsigned f2bf(float f) { unsigned u = __builtin_bit_cast(unsigned, f); return (u + 0x7fffu + ((u >> 16) & 1u)) >> 16; }
__device__ __forceinline__ unsigned pk2(float lo, float hi) { return f2bf(lo) | (f2bf(hi) << 16); }

#define XB_TMO      128
#define XB_XCNT(j)  (256  + 64 * (j))
#define XB_XSUB(j)  (1280 + 64 * (j))
#define XB_XGEN(j)  (2304 + 64 * (j))
#define XB_TOP      3328
#define XB_TOPGEN   3392
#define XCD_BAR_WORDS 3456
#define XB_SPIN_CAP (1u << 18)

__device__ __forceinline__ unsigned xb_ld(unsigned* p)              { return __hip_atomic_load(p, __ATOMIC_RELAXED, __HIP_MEMORY_SCOPE_AGENT); }
__device__ __forceinline__ unsigned xb_add(unsigned* p, unsigned v) { return __hip_atomic_fetch_add(p, v, __ATOMIC_RELAXED, __HIP_MEMORY_SCOPE_AGENT); }
__device__ __forceinline__ unsigned xb_xcc_id() { return (unsigned)__builtin_amdgcn_s_getreg((3 << 11) | 20) & 0xFu; }
#define XB_SPIN(cond, bar) do { unsigned _sp = 0; while (cond) { __builtin_amdgcn_s_sleep(1); \
    if ((++_sp & 255u) == 0u) { if (xb_ld(&(bar)[XB_TMO])) break; if (_sp > XB_SPIN_CAP) { atomicAdd(&(bar)[XB_TMO], 1u); break; } } } } while (0)

struct XcdBarrier {
    unsigned* bar; unsigned x;
    volatile LAS unsigned* st;
};

__device__ __forceinline__ XcdBarrier xcd_barrier_post(unsigned* bar, volatile LAS unsigned* st) {
    XcdBarrier b; b.bar = bar; b.x = xb_xcc_id(); b.st = st;
    if (threadIdx.x == 0) (void)xb_add(&bar[XB_XCNT(b.x)], 1u);
    return b;
}
__device__ __forceinline__ void xcd_barrier_complete(unsigned* bar, unsigned x, unsigned& nloc, unsigned& nx) {
    const unsigned G = gridDim.x * gridDim.y * gridDim.z;
    unsigned sum, cnt, mine, sp = 0u;
    for (;;) {
        sum = 0u; cnt = 0u; mine = 0u;
#pragma unroll
        for (unsigned j = 0; j < 16; ++j) { const unsigned c = xb_ld(&bar[XB_XCNT(j)]); sum += c; cnt += (c > 0u) ? 1u : 0u; mine = (j == x) ? c : mine; }
        if (sum == G) break;
        __builtin_amdgcn_s_sleep(1);
        if ((++sp & 255u) == 0u) { if (xb_ld(&bar[XB_TMO])) break; if (sp > XB_SPIN_CAP) { atomicAdd(&bar[XB_TMO], 1u); break; } }
    }
    nloc = mine > 0u ? mine : 1u; nx = cnt > 0u ? cnt : 1u;
}

__device__ __forceinline__ void xcd_barrier(const XcdBarrier& b) {
    asm volatile("s_waitcnt vmcnt(0)" ::: "memory");
    __syncthreads();
    if (threadIdx.x == 0) {
        unsigned* bar = b.bar;
        __builtin_amdgcn_s_waitcnt(0);
        unsigned nloc = b.st[0], nx = b.st[1];
        if (nloc == 0u) { xcd_barrier_complete(bar, b.x, nloc, nx); b.st[0] = nloc; b.st[1] = nx; }
        const unsigned old = xb_add(&bar[XB_XSUB(b.x)], 1u);
        const unsigned gen = old / nloc;
        if (old + 1u == (gen + 1u) * nloc) {
            __builtin_amdgcn_fence(__ATOMIC_RELEASE, "agent");
            asm volatile("s_waitcnt vmcnt(0)" ::: "memory");
            const unsigned og = xb_add(&bar[XB_TOP], 1u);
            const unsigned tg = og / nx;
            if (og + 1u == (tg + 1u) * nx) xb_add(&bar[XB_TOPGEN], 1u);
            else XB_SPIN(xb_ld(&bar[XB_TOPGEN]) == tg, bar);
            __builtin_amdgcn_fence(__ATOMIC_ACQUIRE, "agent");
            xb_add(&bar[XB_XGEN(b.x)], 1u);
            asm volatile("s_waitcnt vmcnt(0)" ::: "memory");
        } else {
            XB_SPIN(xb_ld(&bar[XB_XGEN(b.x)]) == gen, bar);
            __builtin_amdgcn_fence(__ATOMIC_ACQUIRE, "agent");
            asm volatile("s_waitcnt vmcnt(0)" ::: "memory");
        }
    }
    __syncthreads();
}

typedef float f32x16 __attribute__((ext_vector_type(16)));
typedef float f32x2 __attribute__((ext_vector_type(2)));
typedef unsigned v2u __attribute__((ext_vector_type(2)));
typedef __bf16 bf16x2_t __attribute__((ext_vector_type(2)));
#define DI __device__ __forceinline__
#define MFMA32(a, b, c) __builtin_amdgcn_mfma_f32_32x32x16_bf16((a), (b), (c), 0, 0, 0)
#define MFMA16(a, b, c) __builtin_amdgcn_mfma_f32_16x16x32_bf16((a), (b), (c), 0, 0, 0)
DI unsigned cvtpk(float lo, float hi) { f32x2 v = {lo, hi}; bf16x2_t b = __builtin_convertvector(v, bf16x2_t); return __builtin_bit_cast(unsigned, b); }
DI float bf2f(unsigned short b) { return __uint_as_float((unsigned)b << 16); }
DI float bflo(unsigned w) { return __uint_as_float(w << 16); }
DI float bfhi(unsigned w) { return __uint_as_float(w & 0xffff0000u); }
DI bf16x8 pack8(const f32x4& a, const f32x4& b) { v4u p; p.x = cvtpk(a[0], a[1]); p.y = cvtpk(a[2], a[3]); p.z = cvtpk(b[0], b[1]); p.w = cvtpk(b[2], b[3]); return __builtin_bit_cast(bf16x8, p); }
DI float wave_sum(float v) {
#pragma unroll
    for (int o = 1; o < 64; o <<= 1) v += __shfl_xor(v, o);
    return v;
}
DI float wave_max(float v) {
#pragma unroll
    for (int o = 1; o < 64; o <<= 1) v = fmaxf(v, __shfl_xor(v, o));
    return v;
}
DI float row16_sum(float v) {
    v += __int_as_float(__builtin_amdgcn_update_dpp(0, __float_as_int(v), 0x128, 0xf, 0xf, false));
    v += __int_as_float(__builtin_amdgcn_update_dpp(0, __float_as_int(v), 0x124, 0xf, 0xf, false));
    v += __int_as_float(__builtin_amdgcn_update_dpp(0, __float_as_int(v), 0x122, 0xf, 0xf, false));
    v += __int_as_float(__builtin_amdgcn_update_dpp(0, __float_as_int(v), 0x121, 0xf, 0xf, false));
    return v;
}
DI float silu_f(float x) { return x * __builtin_amdgcn_rcpf(1.0f + __builtin_amdgcn_exp2f(-LOG2E * x)); }
DI float silu_acc(float x) { return x / (1.0f + __expf(-x)); }
DI int crow32(int r, int hl) { return (r & 3) + 8 * (r >> 2) + 4 * hl; }

__constant__ float ROPE_HI[32] = {1.591549367e-01f, 1.193493679e-01f, 8.949939907e-02f, 6.711508334e-02f, 5.032921210e-02f, 3.774158657e-02f, 2.830219641e-02f, 2.122365311e-02f, 1.591549441e-02f, 1.193493698e-02f, 8.949940093e-03f, 6.711508147e-03f, 5.032921210e-03f, 3.774158424e-03f, 2.830219688e-03f, 2.122365171e-03f, 1.591549488e-03f, 1.193493721e-03f, 8.949940093e-04f, 6.711508031e-04f, 5.032921326e-04f, 3.774158540e-04f, 2.830219455e-04f, 2.122365258e-04f, 1.591549371e-04f, 1.193493736e-04f, 8.949940093e-05f, 6.711508468e-05f, 5.032921035e-05f, 3.774158540e-05f, 2.830219637e-05f, 2.122365186e-05f};
__constant__ float ROPE_LO[32] = {6.420638243e-09f, 2.294664903e-09f, 2.542919653e-09f, -3.316028840e-10f, 5.173299289e-12f, -1.848551645e-09f, -5.826552019e-10f, -3.431038786e-10f, -1.029942312e-10f, 4.320196978e-11f, 6.802745173e-11f, 1.531042237e-10f, 5.173298855e-13f, 4.797548470e-11f, -1.048316503e-10f, 1.053879969e-10f, -5.686555046e-11f, -1.896286773e-11f, 6.802744999e-12f, 2.695195456e-11f, -1.158979943e-11f, -6.843983713e-12f, 1.279990003e-11f, 1.807650600e-12f, 5.954976963e-12f, -3.351478166e-12f, 6.802744674e-13f, -1.670379113e-12f, 1.751403167e-12f, -6.843983930e-13f, -5.389994549e-13f, 9.083608431e-13f};

struct Args { const float* in[21]; float* out; unsigned char* ws; int ph_lo, ph_hi, li, pad; };
enum { I_XP = 0, I_XS, I_CK, I_CV, I_SCONV, I_SDELTA, I_WIN, I_BATTN, I_SINKS, I_WCONV, I_ALOG, I_DTB, I_NORMW, I_WOUT, I_LN1G, I_LN1B, I_WGATE, I_WUP, I_WDOWN, I_LN2G, I_LN2B };

template <int MODE> DI int rowmap(int n) { return MODE == 0 ? n : (256 * (n >> 7) + (n & 127) + (MODE == 2 ? 128 : 0)); }
template <int MODE> DI void p0_tile(const float* __restrict__ W, int N, int K, bf16* __restrict__ WT, LAS unsigned short* scr, int kb, int nb, int lane) {
    const int k0 = 64 * kb, n0 = 64 * nb, n = n0 + lane; const bool ok = n < N;
    const float* src = W + (size_t)k0 * N + (ok ? n : 0);
#pragma unroll 32
    for (int kk = 0; kk < 64; ++kk) { const float v = __builtin_nontemporal_load(src + (size_t)kk * N); scr[kk * 66 + lane] = (unsigned short)f2bf(ok ? v : 0.f); }
    LDS_WAIT(); asm volatile("" ::: "memory");
    const int c = lane & 7, nn = lane >> 3;
#pragma unroll
    for (int p = 0; p < 8; ++p) { const int nl = nn + 8 * p, ng = n0 + nl;
        const LAS unsigned short* s = scr + (8 * c) * 66 + nl;
        v4u o; o.x = (unsigned)s[0] | ((unsigned)s[66] << 16); o.y = (unsigned)s[2 * 66] | ((unsigned)s[3 * 66] << 16); o.z = (unsigned)s[4 * 66] | ((unsigned)s[5 * 66] << 16); o.w = (unsigned)s[6 * 66] | ((unsigned)s[7 * 66] << 16);
        if (ng < N) *(v4u*)(WT + (size_t)rowmap<MODE>(ng) * K + k0 + 8 * c) = o; }
    LDS_WAIT(); asm volatile("" ::: "memory");
}
constexpr int CV_T_IN = 64 * 177, CV_T_OUT = 64 * 64, CV_T_G = 64 * 172, CV_T_DN = 172 * 64;
constexpr int CV_T3 = CV_T_OUT + CV_T_DN, CV_T4 = 2 * CV_T_G;
DI void cv_tile3(const Args& A, LAS unsigned short* scr, int r, int lane) {
    if (r < CV_T_OUT) p0_tile<0>(A.in[I_WOUT], DM, DM, (bf16*)(A.ws + WS_WOUT), scr, r / 64, r % 64, lane);
    else { r -= CV_T_OUT; p0_tile<0>(A.in[I_WDOWN], DM, FF, (bf16*)(A.ws + WS_WDN), scr, r / 64, r % 64, lane); }
}
DI void cv_tile4(const Args& A, LAS unsigned short* scr, int r, int lane) {
    if (r < CV_T_G) p0_tile<1>(A.in[I_WGATE], FF, DM, (bf16*)(A.ws + WS_WGU), scr, r / 172, r % 172, lane);
    else { r -= CV_T_G; p0_tile<2>(A.in[I_WUP], FF, DM, (bf16*)(A.ws + WS_WGU), scr, r / 172, r % 172, lane); }
}
DI void cv_pull3(const Args& A, LAS unsigned char* lds, gu32* ctr, int t0, int t1, int wave, int lane) {
    LAS unsigned short* scr = (LAS unsigned short*)(lds + RING_OFF + wave * 8448);
    for (;;) { int b = 0; if (lane == 0) b = (int)__hip_atomic_fetch_add(ctr, 4u, RLX_AGENT); b = t0 + __builtin_amdgcn_readfirstlane(b);
        if (b >= t1) break;
        for (int r = b; r < b + 4 && r < t1; ++r) cv_tile3(A, scr, r, lane); }
}
DI void p0_prologue(const Args& A, LAS unsigned char* lds, int gw, int NGW, int wave, int lane) {
    unsigned char* ws = A.ws;
    LAS unsigned short* scr = (LAS unsigned short*)(lds + RING_OFF + wave * 8448);
    for (int it = gw; it < CV_T_IN + CV_T4; it += NGW) {
        if (it < CV_T4) cv_tile4(A, scr, it, lane);
        else { const int r = it - CV_T4; p0_tile<0>(A.in[I_WIN], INW, DM, (bf16*)(ws + WS_WIN), scr, r / 177, r % 177, lane); } }
    for (int m = gw; m < MPAD + (INP - INW); m += NGW) {
        if (m < MPAD) {
            v2u* o = (v2u*)((bf16*)(ws + WS_XB) + (size_t)m * DM) + lane;
            if (m < MROWS) { const f32x4* xr = (const f32x4*)(m < TP ? A.in[I_XP] + (size_t)m * DM : A.in[I_XS] + (size_t)(m - TP) * DM) + lane;
#pragma unroll 8
                for (int j = 0; j < 16; ++j) { const f32x4 v = __builtin_nontemporal_load(xr + 64 * j); v2u w; w.x = cvtpk(v[0], v[1]); w.y = cvtpk(v[2], v[3]); o[64 * j] = w; } }
            else {
#pragma unroll 8
                for (int j = 0; j < 16; ++j) o[64 * j] = (v2u){0u, 0u}; }
        } else {
            v4u* o = (v4u*)((bf16*)(ws + WS_WIN) + (size_t)(INW + (m - MPAD)) * DM) + lane;
#pragma unroll
            for (int j = 0; j < 8; ++j) o[64 * j] = (v4u){0u, 0u, 0u, 0u};
        }
    }
    const int gt = gw * 64 + lane, NGT = NGW * 64;
    for (int i = gt; i < INP; i += NGT) ((float*)(ws + WS_BIASP))[i] = i < 3072 ? A.in[I_BATTN][i] : 0.f;
    for (int i = gt; i < 8193 * 32; i += NGT) { const int pos = i >> 5, f = i & 31; const float p = (float)pos, hi = ROPE_HI[f];
        const float r0 = p * hi, e0 = __builtin_fmaf(p, hi, -r0) + p * ROPE_LO[f]; float fr = r0 - __builtin_floorf(r0) + e0;
        f32x2 cs; cs.x = __builtin_amdgcn_cosf(fr); cs.y = __builtin_amdgcn_sinf(fr); ((f32x2*)(ws + WS_ROPE))[i] = cs; }
}

DI void p2_token(const Args& A, int row, int lane) {
    unsigned char* ws = A.ws; float* out = A.out;
    const bool smp = row >= TP; const int n = row - TP; const int pos = smp ? TP : row;
    const bf16* pr = (const bf16*)(ws + WS_PROJ) + (size_t)row * INP;
    const int part = lane & 3, hs = lane >> 2, d0 = 8 * part;
    f32x4 cs[4];
    { const f32x4* tp = (const f32x4*)((const float*)(ws + WS_ROPE) + ((size_t)pos * 32 + d0) * 2);
#pragma unroll
      for (int j = 0; j < 4; ++j) cs[j] = tp[j]; }
#pragma unroll
    for (int ps = 0; ps < 3; ++ps) { const int hh = 16 * ps + hs;
        if (hh < 40) {
            const v4u a = *(const v4u*)(pr + hh * 64 + d0), b = *(const v4u*)(pr + hh * 64 + 32 + d0);
            float x1[8], x2[8], o1[8], o2[8];
#pragma unroll
            for (int j = 0; j < 4; ++j) { x1[2 * j] = bflo(a[j]); x1[2 * j + 1] = bfhi(a[j]); x2[2 * j] = bflo(b[j]); x2[2 * j + 1] = bfhi(b[j]); }
#pragma unroll
            for (int j = 0; j < 8; ++j) { const float c = cs[j >> 1][(j & 1) * 2], s = cs[j >> 1][(j & 1) * 2 + 1]; o1[j] = x1[j] * c - x2[j] * s; o2[j] = x2[j] * c + x1[j] * s; }
            if (hh < 32) {
                if (!smp) { bf16* q = (bf16*)(ws + WS_QB) + (size_t)row * 2048 + hh * 64 + d0;
                    v4u w1, w2;
#pragma unroll
                    for (int j = 0; j < 4; ++j) { w1[j] = cvtpk(o1[2 * j] * QSCALE, o1[2 * j + 1] * QSCALE); w2[j] = cvtpk(o2[2 * j] * QSCALE, o2[2 * j + 1] * QSCALE); }
                    *(v4u*)q = w1; *(v4u*)(q + 32) = w2;
                } else { float* q = (float*)(ws + WS_SQA) + (size_t)n * 2048 + hh * 64 + d0;
#pragma unroll
                    for (int j = 0; j < 8; ++j) { q[j] = o1[j] * QSCALE; q[32 + j] = o2[j] * QSCALE; } }
            } else { const int kvh = hh - 32;
                if (!smp) { bf16* k = (bf16*)(ws + WS_KB) + (size_t)row * 512 + kvh * 64 + d0;
                    v4u w1, w2;
#pragma unroll
                    for (int j = 0; j < 4; ++j) { w1[j] = cvtpk(o1[2 * j], o1[2 * j + 1]); w2[j] = cvtpk(o2[2 * j], o2[2 * j + 1]); }
                    *(v4u*)k = w1; *(v4u*)(k + 32) = w2; }
                if (smp || row >= TP - 128) { float* k = smp ? out + O_SK + ((size_t)n * 128 + 127) * 512 + kvh * 64 + d0 : out + O_PK + (size_t)(row - (TP - 128)) * 512 + kvh * 64 + d0;
#pragma unroll
                    for (int j = 0; j < 8; ++j) { k[j] = o1[j]; k[32 + j] = o2[j]; } }
            }
        }
    }
    if (smp || row >= TP - 128) { float* v = smp ? out + O_SV + ((size_t)n * 128 + 127) * 512 : out + O_PV + (size_t)(row - (TP - 128)) * 512;
        const v4u a = *(const v4u*)(pr + OFF_V + 8 * lane);
#pragma unroll
        for (int j = 0; j < 4; ++j) { v[8 * lane + 2 * j] = bflo(a[j]); v[8 * lane + 2 * j + 1] = bfhi(a[j]); } }
    if (smp && lane < 16) {   const float* ab = (const float*)(ws + WS_AB) + (size_t)row * 32; const float a = ab[lane] + A.in[I_DTB][lane], b = ab[16 + lane];
        const float sp = a > 20.f ? a : log1pf(expf(a)); const float g = -expf(A.in[I_ALOG][lane]) * sp; const float be = 1.0f / (1.0f + expf(-b));
        if (!smp) { float* gb = (float*)(ws + WS_GB) + (size_t)row * 32; gb[lane] = g; gb[16 + lane] = be; }
        else { float* gs = (float*)(ws + WS_SQA); (void)gs; float* gb2 = (float*)(ws + WS_GL) + 4096 + (size_t)n * 32; gb2[lane] = g; gb2[16 + lane] = be; } }
}

DI void p2_conv4(const Args& A, int grp, int ps, int lane) {
    unsigned char* ws = A.ws; float* out = A.out;
    const int t0 = 4 * grp, c0 = 512 * ps + 8 * lane;
    const bf16* pr = (const bf16*)(ws + WS_PROJ) + OFF_PRE + c0;
    v4u xr[7];
#pragma unroll
    for (int j = 0; j < 7; ++j) { const int r = t0 - 3 + j; xr[j] = r >= 0 ? *(const v4u*)(pr + (size_t)r * INP) : (v4u){0u, 0u, 0u, 0u}; }
    f32x4 w[4][2];
#pragma unroll
    for (int j = 0; j < 4; ++j) { const f32x4* wp = (const f32x4*)(A.in[I_WCONV] + (size_t)j * CONVD + c0); w[j][0] = wp[0]; w[j][1] = wp[1]; }
    float x[7][8];
#pragma unroll
    for (int j = 0; j < 7; ++j)
#pragma unroll
        for (int e = 0; e < 4; ++e) { x[j][2 * e] = bflo(xr[j][e]); x[j][2 * e + 1] = bfhi(xr[j][e]); }
    const int cc = (ps & 3) * 512 + 8 * lane;
    bf16* dst = (bf16*)(ws + (ps < 4 ? WS_QH : (ps < 8 ? WS_KH : WS_VH))) + (size_t)t0 * 2048 + cc;
#pragma unroll
    for (int t = 0; t < 4; ++t) { float y[8]; float ss = 0.f;
#pragma unroll
        for (int e = 0; e < 8; ++e) { float a = 0.f;
#pragma unroll
            for (int j = 0; j < 4; ++j) a += w[j][e >> 2][e & 3] * x[t + j][e];
            y[e] = silu_acc(a); ss += y[e] * y[e]; }
        if (ps < 8) { ss = row16_sum(ss);
            const float rn = (1.0f / sqrtf(ss + RMS_EPS)) * (ps < 4 ? 0.08838834764831845f : 1.0f);
#pragma unroll
            for (int e = 0; e < 8; ++e) y[e] *= rn; }
        v4u o;
#pragma unroll
        for (int e = 0; e < 4; ++e) o[e] = cvtpk(y[2 * e], y[2 * e + 1]);
        *(v4u*)(dst + (size_t)t * 2048) = o;
        if (t0 + t >= TP - 3) { float* d = out + O_PC + (size_t)(t0 + t - (TP - 3)) * CONVD + c0;
            *(f32x4*)d = (f32x4){x[t + 3][0], x[t + 3][1], x[t + 3][2], x[t + 3][3]}; *(f32x4*)(d + 4) = (f32x4){x[t + 3][4], x[t + 3][5], x[t + 3][6], x[t + 3][7]}; }
    }
}
DI void p2_convs(const Args& A, int n, int ps, int lane) {
    unsigned char* ws = A.ws; float* out = A.out;
    const int c0 = 512 * ps + 8 * lane;
    float x[4][8];
#pragma unroll
    for (int j = 0; j < 3; ++j) { const f32x4* sp = (const f32x4*)(A.in[I_SCONV] + ((size_t)n * 3 + j) * CONVD + c0); const f32x4 s0 = sp[0], s1 = sp[1];
#pragma unroll
        for (int e = 0; e < 4; ++e) { x[j][e] = s0[e]; x[j][4 + e] = s1[e]; } }
    { const v4u a = *(const v4u*)((const bf16*)(ws + WS_PROJ) + (size_t)(TP + n) * INP + OFF_PRE + c0);
#pragma unroll
      for (int e = 0; e < 4; ++e) { x[3][2 * e] = bflo(a[e]); x[3][2 * e + 1] = bfhi(a[e]); } }
    float y[8]; float ss = 0.f;
#pragma unroll
    for (int e = 0; e < 8; ++e) y[e] = 0.f;
#pragma unroll
    for (int j = 0; j < 4; ++j) { const f32x4* wp = (const f32x4*)(A.in[I_WCONV] + (size_t)j * CONVD + c0); const f32x4 w0 = wp[0], w1 = wp[1];
#pragma unroll
        for (int e = 0; e < 4; ++e) { y[e] += w0[e] * x[j][e]; y[4 + e] += w1[e] * x[j][4 + e]; } }
#pragma unroll
    for (int e = 0; e < 8; ++e) { y[e] = silu_acc(y[e]); ss += y[e] * y[e]; }
    if (ps < 8) { ss = row16_sum(ss);
        const float rn = (1.0f / sqrtf(ss + RMS_EPS)) * (ps < 4 ? 0.08838834764831845f : 1.0f);
#pragma unroll
        for (int e = 0; e < 8; ++e) y[e] *= rn; }
    float* dst = (float*)(ws + (ps < 4 ? WS_SQD : (ps < 8 ? WS_SKD : WS_SVD))) + (size_t)n * 2048 + (ps & 3) * 512 + 8 * lane;
    *(f32x4*)dst = (f32x4){y[0], y[1], y[2], y[3]}; *(f32x4*)(dst + 4) = (f32x4){y[4], y[5], y[6], y[7]};
    float* d = out + O_SC + (size_t)n * 3 * CONVD + c0;
#pragma unroll
    for (int j = 0; j < 3; ++j) { *(f32x4*)(d + (size_t)j * CONVD) = (f32x4){x[j + 1][0], x[j + 1][1], x[j + 1][2], x[j + 1][3]}; *(f32x4*)(d + (size_t)j * CONVD + 4) = (f32x4){x[j + 1][4], x[j + 1][5], x[j + 1][6], x[j + 1][7]}; }
}

constexpr size_t WS_GBS = WS_GL + 16384;

DI void p3_pair(const Args& A, int it0, LAS unsigned char* ldsw, int tid, int wave, int lane) {
    unsigned char* ws = A.ws;
    const int half = tid >> 8, t = tid & 255, w4 = wave & 3, it = it0 + half;
    const int hh = it >> 7, ck = it & 127, t0 = ck * 64;
    LAS unsigned char* lds = ldsw + half * 53248;
    LAS unsigned short* KH = (LAS unsigned short*)(lds);
    LAS unsigned short* QH = (LAS unsigned short*)(lds + 17408);
    LAS float* AMT = (LAS float*)(lds + 34816);
    LAS float* CUM = (LAS float*)(lds + 52224);
    LAS float* BET = CUM + 64;
    {   const int g4 = t >> 4, ch = t & 15;
#pragma unroll 1
        for (int which = 0; which < 2; ++which) {
            const bf16* pr = (const bf16*)(ws + WS_PROJ) + OFF_PRE + which * 2048 + hh * 128 + 8 * ch; const float* wc = A.in[I_WCONV] + which * 2048 + hh * 128 + 8 * ch;
            v4u xr[7];
#pragma unroll
            for (int j = 0; j < 7; ++j) { const int row = t0 + 4 * g4 - 3 + j; xr[j] = row >= 0 ? *(const v4u*)(pr + (size_t)row * INP) : (v4u){0u, 0u, 0u, 0u}; }
            f32x4 w[4][2];
#pragma unroll
            for (int j = 0; j < 4; ++j) { w[j][0] = *(const f32x4*)(wc + (size_t)j * CONVD); w[j][1] = *(const f32x4*)(wc + (size_t)j * CONVD + 4); }
            LAS unsigned short* dst = (which ? KH : QH) + (4 * g4) * 136 + ch * 8;
#pragma unroll
            for (int tt = 0; tt < 4; ++tt) { float y[8]; float ss = 0.f;
#pragma unroll
                for (int e = 0; e < 8; ++e) { float a = 0.f;
#pragma unroll
                    for (int j = 0; j < 4; ++j) { const unsigned wd = xr[tt + j][e >> 1]; a += w[j][e >> 2][e & 3] * ((e & 1) ? bfhi(wd) : bflo(wd)); }
                    y[e] = silu_acc(a); ss += y[e] * y[e]; }
                ss = row16_sum(ss);
                const float rn = (1.0f / sqrtf(ss + RMS_EPS)) * (which == 0 ? 0.08838834764831845f : 1.0f);
                v4u o;
#pragma unroll
                for (int e = 0; e < 4; ++e) o[e] = cvtpk(y[2 * e] * rn, y[2 * e + 1] * rn);
                *(LAS v4u*)(dst + tt * 136) = o;
                if (ck == NCHUNK - 1 && 4 * g4 + tt >= 61) { float* d = A.out + O_PC + (size_t)(4 * g4 + tt - 61) * CONVD + which * 2048 + hh * 128 + 8 * ch; const v4u rw = xr[tt + 3];
                    *(f32x4*)d = (f32x4){bflo(rw[0]), bfhi(rw[0]), bflo(rw[1]), bfhi(rw[1])}; *(f32x4*)(d + 4) = (f32x4){bflo(rw[2]), bfhi(rw[2]), bflo(rw[3]), bfhi(rw[3])}; }
            }
        }
    }
    __builtin_amdgcn_sched_barrier(0);
    float x[64];
    if (t >= 128) { const int c = t - 128; const bf16* pv = (const bf16*)(ws + WS_PROJ) + OFF_PRE + 4096 + hh * 128 + c; const float* wc = A.in[I_WCONV] + 4096 + hh * 128 + c;
        const float w0 = wc[0], w1 = wc[CONVD], w2 = wc[2 * CONVD], w3 = wc[3 * CONVD];
        float e0, e1, e2;
        { const int r0 = t0 - 3; e0 = r0 >= 0 ? bf2f(pv[(size_t)r0 * INP]) : 0.f; e1 = r0 + 1 >= 0 ? bf2f(pv[(size_t)(r0 + 1) * INP]) : 0.f; e2 = r0 + 2 >= 0 ? bf2f(pv[(size_t)(r0 + 2) * INP]) : 0.f; }
#pragma unroll
        for (int i = 0; i < 64; ++i) x[i] = bf2f(pv[(size_t)(t0 + i) * INP]);
        if (ck == NCHUNK - 1) { float* d = A.out + O_PC + 4096 + hh * 128 + c; d[0] = x[61]; d[CONVD] = x[62]; d[2 * CONVD] = x[63]; }
#pragma unroll
        for (int i = 63; i >= 0; --i) { const float a = i >= 3 ? x[i - 3] : (i == 2 ? e2 : (i == 1 ? e1 : e0)), b = i >= 2 ? x[i - 2] : (i == 1 ? e2 : e1), cc2 = i >= 1 ? x[i - 1] : e2;
            x[i] = silu_acc(w0 * a + w1 * b + w2 * cc2 + w3 * x[i]); }
    }
    if (t < 64) {
        const float* ab = (const float*)(ws + WS_AB) + (size_t)(t0 + t) * 32; const float a = ab[hh] + A.in[I_DTB][hh], bb = ab[16 + hh];
        const float sp = a > 20.f ? a : log1pf(expf(a)); float c = -expf(A.in[I_ALOG][hh]) * sp;
#pragma unroll
        for (int o = 1; o < 64; o <<= 1) { const float tt = __shfl_up(c, o); if (lane >= o) c += tt; }
        CUM[t] = c; BET[t] = 1.0f / (1.0f + expf(-bb)); }
    __syncthreads();
    {
        const int ti = (w4 >> 1) & 1, tj = w4 & 1, l31 = lane & 31, hl = lane >> 5;
        const LAS unsigned short* Bs = KH + (32 * tj + l31) * 136 + 8 * hl;
        const int j = 32 * tj + l31; const float cj = CUM[j];
        bf16* att = (bf16*)(ws + WS_CAT) + (size_t)it * 4096;
#pragma unroll
        for (int which = 0; which < 2; ++which) {
            const LAS unsigned short* As = (which ? QH : KH) + (32 * ti + l31) * 136 + 8 * hl;
            f32x16 xx;
#pragma unroll
            for (int r = 0; r < 16; ++r) xx[r] = 0.f;
#pragma unroll
            for (int s = 0; s < 8; ++s) { const bf16x8 a = *(const LAS bf16x8*)(As + 16 * s), b = *(const LAS bf16x8*)(Bs + 16 * s); xx = MFMA32(a, b, xx); }
#pragma unroll
            for (int r = 0; r < 16; ++r) { const int i = 32 * ti + crow32(r, hl); const float dec = __expf(fminf(CUM[i] - cj, 0.f));
                if (which == 0) { if (i > j) AMT[j * 68 + i] = BET[i] * xx[r] * dec; }
                else { const float v = i >= j ? xx[r] * dec : 0.f; att[i * 64 + j] = (bf16)f2bf(v); } }
        }
    }
    __syncthreads();
    if (t < 128) { const int c = t; const float cl = CUM[63];
        bf16* kd = (bf16*)(ws + WS_CKD) + (size_t)it * 8192 + c * 64;
#pragma unroll
        for (int g = 0; g < 8; ++g) { float kv[8];
#pragma unroll
            for (int e = 0; e < 8; ++e) { const int tt = 8 * g + e; const float k = bf2f(KH[tt * 136 + c]); const float cu = CUM[tt]; kv[e] = k * __expf(cl - cu); x[tt] = k * BET[tt] * __expf(cu); }
            v4u w; w.x = cvtpk(kv[0], kv[1]); w.y = cvtpk(kv[2], kv[3]); w.z = cvtpk(kv[4], kv[5]); w.w = cvtpk(kv[6], kv[7]); *(v4u*)(kd + 8 * g) = w; }
    } else {
#pragma unroll
        for (int i = 0; i < 64; ++i) x[i] *= BET[i];
    }
#pragma unroll
    for (int j = 0; j < 63; ++j) { const float xj = x[j];
#pragma unroll
        for (int a4 = (j + 1) / 4; a4 < 16; ++a4) { const f32x4 av = *(const LAS f32x4*)(AMT + j * 68 + 4 * a4);
#pragma unroll
            for (int e = 0; e < 4; ++e) { const int i = 4 * a4 + e; if (i > j) x[i] -= av[e] * xj; } } }
    if (t < 128) { bf16* wn = (bf16*)(ws + WS_CWN) + (size_t)it * 8192 + t;
#pragma unroll
        for (int i = 0; i < 64; ++i) wn[i * 128] = (bf16)f2bf(-x[i]);
    } else { float* u = (float*)(ws + WS_CU) + (size_t)it * 8192 + (t - 128);
#pragma unroll
        for (int i = 0; i < 64; ++i) u[i * 128] = x[i];
    }
    {
        bf16* qd = (bf16*)(ws + WS_CQD) + (size_t)it * 8192;
#pragma unroll
        for (int p = 0; p < 4; ++p) { const int c = t + 256 * p, r = c >> 4, ch = c & 15; const float ga = __expf(CUM[r]);
            const v4u a = *(const LAS v4u*)(QH + r * 136 + ch * 8); v4u w;
#pragma unroll
            for (int e = 0; e < 4; ++e) w[e] = cvtpk(bflo(a[e]) * ga, bfhi(a[e]) * ga);
            *(v4u*)(qd + r * 128 + ch * 8) = w; }
        if (t == 0) ((float*)(ws + WS_GL))[it] = __expf(CUM[63]);
    }
    __syncthreads();
}

DI float rdlane(float v, int l) { return __int_as_float(__builtin_amdgcn_readlane(__float_as_int(v), l)); }
constexpr int SCAN_NCW = 2;
constexpr int SCAN_SLOT = 32768 + 4096 * SCAN_NCW, SCAN_NS = 3, SCAN_PIECES = 8 + SCAN_NCW;
DI void p4_scan_wg(const Args& A, int item, LAS unsigned char* lds, int wave, int lane) {
    unsigned char* ws = A.ws;
#if defined(PROBE_MASK)
    const bool x_nost = A.pad & 16, x_nocomp = A.pad & 32, x_noload = A.pad & 64;
#else
    constexpr bool x_nost = false, x_nocomp = false, x_noload = false;
#endif
    constexpr int NPART = 8 / SCAN_NCW, URB = 64 * SCAN_NCW, UCPR = 4 * SCAN_NCW, URPP = 1024 / URB;
    const int hh = item / NPART, hf = item % NPART;
    const unsigned char* Wn = ws + WS_CWN + (size_t)hh * 128 * 16384; const unsigned char* Kd = ws + WS_CKD + (size_t)hh * 128 * 16384; const unsigned char* U = ws + WS_CU + (size_t)hh * 128 * 32768 + hf * URB;
    if (wave >= 4) {
        const int lj = wave - 4;
        unsigned off[SCAN_PIECES];
#pragma unroll
        for (int i = 0; i < SCAN_PIECES; ++i) { const int p = lj + 4 * i;
            if (i < 4) { const int row = 4 * p + (lane >> 4), pos = lane & 15, f = (row & 3) | (((row >> 3) & 3) << 2); off[i] = (unsigned)(row * 256 + 16 * (pos ^ f)); }
            else if (i < 8) { const int pp = p - 16, row = 8 * pp + (lane >> 3), pos = lane & 7, f = ((row >> 1) & 1) | (((row >> 3) & 3) << 1); off[i] = (unsigned)(row * 128 + 16 * (pos ^ f)); }
            else { const int pp = p - 32, row = URPP * pp + lane / UCPR, pos = lane % UCPR, f = UCPR >= 8 ? ((row >> 3) & 1) << 2 : 0; off[i] = (unsigned)(row * 512 + 16 * (pos ^ f)); } }
        v4u buf[2][SCAN_PIECES];
#define SCAN_LD(c, R) do { const unsigned char* w_ = Wn + (size_t)(c) * 16384; const unsigned char* k_ = Kd + (size_t)(c) * 16384; const unsigned char* u_ = U + (size_t)(c) * 32768; \
        _Pragma("unroll") for (int i = 0; i < 4; ++i) buf[R][i] = *(const v4u*)(w_ + off[i]); \
        _Pragma("unroll") for (int i = 4; i < 8; ++i) buf[R][i] = *(const v4u*)(k_ + off[i]); \
        _Pragma("unroll") for (int i = 8; i < SCAN_PIECES; ++i) buf[R][i] = *(const v4u*)(u_ + off[i]); } while (0)
#define SCAN_ST(c, R) do { LAS unsigned char* sb_ = lds + ((c) % SCAN_NS) * SCAN_SLOT + 1024 * lj + 16 * lane; \
        _Pragma("unroll") for (int i = 0; i < 4; ++i) *(LAS v4u*)(sb_ + 4096 * i) = buf[R][i]; \
        _Pragma("unroll") for (int i = 4; i < 8; ++i) *(LAS v4u*)(sb_ + 16384 + 4096 * (i - 4)) = buf[R][i]; \
        _Pragma("unroll") for (int i = 8; i < SCAN_PIECES; ++i) *(LAS v4u*)(sb_ + 32768 + 4096 * (i - 8)) = buf[R][i]; } while (0)
        if (x_noload) { for (int b = 0; b < NCHUNK + 1; ++b) { asm volatile("" ::: "memory"); __builtin_amdgcn_s_barrier(); } return; }
        SCAN_LD(0, 0); SCAN_LD(1, 1); SCAN_ST(0, 0); SCAN_LD(2, 0); SCAN_ST(1, 1); SCAN_LD(3, 1);
        asm volatile("s_waitcnt lgkmcnt(0)" ::: "memory"); __builtin_amdgcn_s_barrier(); asm volatile("" ::: "memory");
#pragma unroll 1
        for (int c2 = 0; c2 < NCHUNK; c2 += 2) {
#define SCAN_STEP(u) do { const int ck = c2 + (u); if (ck + 2 < NCHUNK) { SCAN_ST(ck + 2, (u)); if (ck + 4 < NCHUNK) SCAN_LD(ck + 4, (u)); } \
            asm volatile("s_waitcnt lgkmcnt(0)" ::: "memory"); __builtin_amdgcn_s_barrier(); asm volatile("" ::: "memory"); } while (0)
            SCAN_STEP(0); SCAN_STEP(1);
#undef SCAN_STEP
        }
#undef SCAN_LD
#undef SCAN_ST
    } else if (wave >= SCAN_NCW) {
        for (int b = 0; b < NCHUNK + 1; ++b) { asm volatile("" ::: "memory"); __builtin_amdgcn_s_barrier(); }
    } else {
        const int q = lane >> 4, cc = lane & 15, cs = hf * SCAN_NCW + wave;
        const int rslot = 8 * (cc >> 2) + (cc & 3);
        const int fK = ((cc >> 1) & 1) | ((cc >> 2) << 1);
        f32x4 S[8];
#pragma unroll
        for (int m = 0; m < 8; ++m) S[m] = (f32x4){0.f, 0.f, 0.f, 0.f};
        const float* GL = (const float*)(ws + WS_GL) + hh * 128; const float gl0 = GL[lane], gl1 = GL[64 + lane];
        bf16* ST = (bf16*)(ws + WS_ST) + ((size_t)hh * 128 * 128 + cs * 16 + cc) * 128 + 8 * q;
        bf16* UT = (bf16*)(ws + WS_UNT) + ((size_t)hh * 128 * 128 + cs * 16 + cc) * 64 + 8 * q;
        if (x_nocomp) { for (int b = 0; b < NCHUNK + 1; ++b) { asm volatile("" ::: "memory"); __builtin_amdgcn_s_barrier(); } return; }
        asm volatile("s_waitcnt vmcnt(0)" ::: "memory"); __builtin_amdgcn_s_barrier(); asm volatile("" ::: "memory");
#pragma unroll 1
        for (int ck = 0; ck < NCHUNK; ++ck) {
            const LAS unsigned char* sb = lds + (ck % SCAN_NS) * SCAN_SLOT;
            bf16x8 Sb[4];
#pragma unroll
            for (int s = 0; s < 4; ++s) { Sb[s] = pack8(S[2 * s], S[2 * s + 1]); if (!x_nost) *(bf16x8*)(ST + (size_t)ck * 16384 + 32 * s) = Sb[s]; }
            f32x4 P[4];
#pragma unroll
            for (int mt = 0; mt < 4; ++mt) { const int tb = 32 * (mt >> 1) + 8 * q + 4 * (mt & 1);
#pragma unroll
                for (int r = 0; r < 4; ++r) { const int row = tb + r; P[mt][r] = *(const LAS float*)(sb + 32768 + row * URB + 16 * ((4 * wave + (cc >> 2)) ^ (UCPR >= 8 ? ((row >> 3) & 1) << 2 : 0)) + 4 * (cc & 3)); } }
#pragma unroll
            for (int mt = 0; mt < 4; ++mt) { const int row = 32 * (mt >> 1) + 4 * (mt & 1) + rslot;
#pragma unroll
                for (int s = 0; s < 4; ++s) P[mt] = MFMA16(*(const LAS bf16x8*)(sb + row * 256 + 16 * ((4 * s + q) ^ cc)), Sb[s], P[mt]); }
            bf16x8 Ub[2]; Ub[0] = pack8(P[0], P[1]); Ub[1] = pack8(P[2], P[3]);
            if (!x_nost) { *(bf16x8*)(UT + (size_t)ck * 8192) = Ub[0]; *(bf16x8*)(UT + (size_t)ck * 8192 + 32) = Ub[1]; }
            const float gl = rdlane(ck < 64 ? gl0 : gl1, ck & 63);
#pragma unroll
            for (int m = 0; m < 8; ++m) { const int row = 32 * (m >> 1) + 4 * (m & 1) + rslot; S[m] = S[m] * gl;
#pragma unroll
                for (int s = 0; s < 2; ++s) S[m] = MFMA16(*(const LAS bf16x8*)(sb + 16384 + row * 128 + 16 * ((4 * s + q) ^ fK)), Ub[s], S[m]); }
            asm volatile("s_waitcnt lgkmcnt(0)" ::: "memory"); __builtin_amdgcn_s_barrier(); asm volatile("" ::: "memory");
        }
        float* pd = A.out + O_PD + (size_t)hh * 128 * 128 + cs * 16 + cc;
        if (!x_nost)
#pragma unroll
        for (int m = 0; m < 8; ++m) { const int db = 32 * (m >> 1) + 8 * q + 4 * (m & 1);
#pragma unroll
            for (int r = 0; r < 4; ++r) pd[(db + r) * 128] = S[m][r]; }
    }
}

DI void p4_attn(const Args& A, int item, int lane) {
    unsigned char* ws = A.ws;
    const int qt = item >> 5, h = item & 31, kvh = h >> 2, l31 = lane & 31, hl = lane >> 5;
    const int qpos = 32 * qt + l31;
    const bf16* Qb = (const bf16*)(ws + WS_QB) + (size_t)qpos * 2048 + h * 64 + 8 * hl;
    bf16x8 qf[4];
#pragma unroll
    for (int s = 0; s < 4; ++s) qf[s] = *(const bf16x8*)(Qb + 16 * s);
    const float sink2 = A.in[I_SINKS][h] * LOG2E;
    float mx = sink2;
    f32x16 sc[5];
#pragma unroll
    for (int kk = 0; kk < 5; ++kk) { const int kt = qt - 4 + kk;
        f32x16 x;
#pragma unroll
        for (int r = 0; r < 16; ++r) x[r] = 0.f;
        if (kt >= 0) { const bf16* Kb = (const bf16*)(ws + WS_KB) + (size_t)(32 * kt + l31) * 512 + kvh * 64 + 8 * hl;
#pragma unroll
            for (int s = 0; s < 4; ++s) x = MFMA32(*(const bf16x8*)(Kb + 16 * s), qf[s], x); }
#pragma unroll
        for (int r = 0; r < 16; ++r) { const int diff = qpos - (32 * kt + crow32(r, hl)); const bool ok = (kt >= 0) && diff >= 0 && diff < 128; x[r] = ok ? x[r] : -INFINITY; mx = fmaxf(mx, x[r]); }
        sc[kk] = x; }
    mx = fmaxf(mx, __shfl_xor(mx, 32));
    float l = 0.f;
#pragma unroll
    for (int kk = 0; kk < 5; ++kk)
#pragma unroll
        for (int r = 0; r < 16; ++r) { const float p = __builtin_amdgcn_exp2f(sc[kk][r] - mx); sc[kk][r] = p; l += p; }
    l += __shfl_xor(l, 32); l += __builtin_amdgcn_exp2f(sink2 - mx);
    f32x16 o0, o1;
#pragma unroll
    for (int r = 0; r < 16; ++r) { o0[r] = 0.f; o1[r] = 0.f; }
    const bf16* Vb = (const bf16*)(ws + WS_PROJ) + OFF_V + kvh * 64 + l31;
#pragma unroll
    for (int kk = 0; kk < 5; ++kk) { const int kt = qt - 4 + kk;
        if (kt >= 0) {
#pragma unroll
            for (int s = 0; s < 2; ++s) { v4u pw;
#pragma unroll
                for (int e = 0; e < 4; ++e) pw[e] = cvtpk(sc[kk][8 * s + 2 * e], sc[kk][8 * s + 2 * e + 1]);
                const bf16x8 pb = __builtin_bit_cast(bf16x8, pw);
                v4u v0, v1;
#pragma unroll
                for (int e = 0; e < 4; ++e) { const int k0 = 32 * kt + 16 * s + 8 * ((2 * e) >> 2) + 4 * hl + ((2 * e) & 3), k1 = k0 + 1;
                    const bf16* r0 = Vb + (size_t)k0 * INP; const bf16* r1 = Vb + (size_t)k1 * INP;
                    v0[e] = (unsigned)r0[0] | ((unsigned)r1[0] << 16); v1[e] = (unsigned)r0[32] | ((unsigned)r1[32] << 16); }
                o0 = MFMA32(__builtin_bit_cast(bf16x8, v0), pb, o0); o1 = MFMA32(__builtin_bit_cast(bf16x8, v1), pb, o1); } } }
    const float inv = 1.0f / l;
    bf16* mix = (bf16*)(ws + WS_XB) + (size_t)qpos * DM + h * 64 + 4 * hl;
#pragma unroll
    for (int g = 0; g < 4; ++g) { v2u w0, w1; w0.x = cvtpk(o0[4 * g] * inv, o0[4 * g + 1] * inv); w0.y = cvtpk(o0[4 * g + 2] * inv, o0[4 * g + 3] * inv);
        w1.x = cvtpk(o1[4 * g] * inv, o1[4 * g + 1] * inv); w1.y = cvtpk(o1[4 * g + 2] * inv, o1[4 * g + 3] * inv);
        *(v2u*)(mix + 8 * g) = w0; *(v2u*)(mix + 32 + 8 * g) = w1; }
}

DI void p4_sattn(const Args& A, int item, int lane) {
    unsigned char* ws = A.ws;
    const int n = item >> 3, kvh = item & 7;
    const float* ck = A.in[I_CK] + (size_t)n * 128 * 512 + kvh * 64; const float* cv = A.in[I_CV] + (size_t)n * 128 * 512 + kvh * 64;
    float* ok = A.out + O_SK + (size_t)n * 128 * 512 + kvh * 64; float* ov = A.out + O_SV + (size_t)n * 128 * 512 + kvh * 64;
    const float* qs = (const float*)(ws + WS_SQA) + (size_t)n * 2048 + kvh * 256 + lane;
    float qv[4];
#pragma unroll
    for (int hq = 0; hq < 4; ++hq) qv[hq] = qs[hq * 64];
    float sc[4][2];
#pragma unroll
    for (int half = 0; half < 2; ++half) { const int idx = lane + 64 * half;
        const f32x4* src = (const f32x4*)(idx < 127 ? ck + (size_t)(idx + 1) * 512 : ok + (size_t)127 * 512);
        f32x4 kr[16];
#pragma unroll
        for (int c = 0; c < 16; ++c) kr[c] = __builtin_nontemporal_load(src + c);
        if (idx < 127) { f32x4* dst = (f32x4*)(ok + (size_t)idx * 512);
#pragma unroll
            for (int c = 0; c < 16; ++c) __builtin_nontemporal_store(kr[c], dst + c); }
        float s0 = 0.f, s1 = 0.f, s2 = 0.f, s3 = 0.f;
#pragma unroll
        for (int d = 0; d < 64; ++d) { const float kd = kr[d >> 2][d & 3]; s0 += kd * rdlane(qv[0], d); s1 += kd * rdlane(qv[1], d); s2 += kd * rdlane(qv[2], d); s3 += kd * rdlane(qv[3], d); }
        sc[0][half] = s0; sc[1][half] = s1; sc[2][half] = s2; sc[3][half] = s3; }
#pragma unroll
    for (int hq = 0; hq < 4; ++hq) { const float sink2 = A.in[I_SINKS][4 * kvh + hq] * LOG2E;
        const float m = fmaxf(wave_max(fmaxf(sc[hq][0], sc[hq][1])), sink2);
        const float p0 = __builtin_amdgcn_exp2f(sc[hq][0] - m), p1 = __builtin_amdgcn_exp2f(sc[hq][1] - m);
        const float l = wave_sum(p0 + p1) + __builtin_amdgcn_exp2f(sink2 - m); const float inv = 1.0f / l;
        sc[hq][0] = p0 * inv; sc[hq][1] = p1 * inv; }
    float o[4] = {0.f, 0.f, 0.f, 0.f};
#pragma unroll
    for (int jb = 0; jb < 8; ++jb) {
        float vv[16];
#pragma unroll
        for (int e = 0; e < 16; ++e) { const int j = 16 * jb + e; vv[e] = j < 127 ? __builtin_nontemporal_load(cv + (size_t)(j + 1) * 512 + lane) : ov[(size_t)127 * 512 + lane]; }
#pragma unroll
        for (int e = 0; e < 16; ++e) { const int j = 16 * jb + e; if (j < 127) __builtin_nontemporal_store(vv[e], ov + (size_t)j * 512 + lane); }
#pragma unroll
        for (int e = 0; e < 16; ++e) { const int j = 16 * jb + e;
#pragma unroll
            for (int hq = 0; hq < 4; ++hq) o[hq] += rdlane(sc[hq][j >> 6], j & 63) * vv[e]; } }
    bf16* mix = (bf16*)(ws + WS_XB) + (size_t)(TP + n) * DM + kvh * 256 + lane;
#pragma unroll
    for (int hq = 0; hq < 4; ++hq) mix[hq * 64] = (bf16)f2bf(o[hq]);
}

DI void p4_sdn_pair(const Args& A, int pairIdx, LAS unsigned char* lds, int tid, int lane) {
    unsigned char* ws = A.ws;
    const int half = tid >> 8, t = tid & 255, w4 = t >> 6;
    const int item = 2 * pairIdx + half, n = item >> 4, hh = item & 15;
    LAS float* KV = (LAS float*)(lds + half * 8192);
    LAS float* RED = KV + 384; LAS float* RED2 = KV + 896;
    if (t < 128) { const size_t go = (size_t)n * 2048 + hh * 128 + t;
        KV[t] = ((const float*)(ws + WS_SKD))[go]; KV[128 + t] = ((const float*)(ws + WS_SQD))[go]; KV[256 + t] = ((const float*)(ws + WS_SVD))[go]; }
    const float* gbs = (const float*)(ws + WS_GBS) + (size_t)n * 32; const float eg = __expf(gbs[hh]), be = gbs[16 + hh];
    const size_t so = ((size_t)(n * 16 + hh) * 128 + 32 * w4) * 128 + 2 * lane;
    const float* Sg = A.in[I_SDELTA] + so; float* So = A.out + O_SD + so;
    f32x2 s[32];
#pragma unroll
    for (int i = 0; i < 32; ++i) s[i] = __builtin_nontemporal_load((const f32x2*)(Sg + i * 128));
    __syncthreads();
    f32x2 r = {0.f, 0.f};
#pragma unroll
    for (int i = 0; i < 32; ++i) r += s[i] * KV[32 * w4 + i];
    *(LAS f32x2*)(RED + w4 * 128 + 2 * lane) = r;
    __syncthreads();
    const f32x2 rt = *(const LAS f32x2*)(RED + 2 * lane) + *(const LAS f32x2*)(RED + 128 + 2 * lane) + *(const LAS f32x2*)(RED + 256 + 2 * lane) + *(const LAS f32x2*)(RED + 384 + 2 * lane);
    const f32x2 u = (*(const LAS f32x2*)(KV + 256 + 2 * lane) - rt * eg) * be;
    f32x2 o = {0.f, 0.f};
#pragma unroll
    for (int i = 0; i < 32; ++i) { const float kk = KV[32 * w4 + i], qq = KV[128 + 32 * w4 + i]; const f32x2 sn = s[i] * eg + u * kk; __builtin_nontemporal_store(sn, (f32x2*)(So + i * 128)); o += sn * qq; }
    *(LAS f32x2*)(RED2 + w4 * 128 + 2 * lane) = o;
    __syncthreads();
    if (w4 == 0) {
        const f32x2 ot = *(const LAS f32x2*)(RED2 + 2 * lane) + *(const LAS f32x2*)(RED2 + 128 + 2 * lane) + *(const LAS f32x2*)(RED2 + 256 + 2 * lane) + *(const LAS f32x2*)(RED2 + 384 + 2 * lane);
        const float ss = wave_sum(ot.x * ot.x + ot.y * ot.y); const float rn = 1.0f / sqrtf(ss * (1.0f / 128.0f) + RMS_EPS);
        const unsigned zz = *(const unsigned*)((const bf16*)(ws + WS_PROJ) + (size_t)(TP + n) * INP + OFF_Z + hh * 128 + 2 * lane);
        const f32x2 nw = *(const f32x2*)(A.in[I_NORMW] + 2 * lane);
        const float y0 = ot.x * rn * nw.x * silu_acc(bflo(zz)), y1 = ot.y * rn * nw.y * silu_acc(bfhi(zz));
        *(unsigned*)((bf16*)(ws + WS_XB) + (size_t)(TP + n) * DM + 2048 + hh * 128 + 2 * lane) = cvtpk(y0, y1);
    }
    __syncthreads();
}

DI void p5_item(const Args& A, int it, LAS unsigned char* lds, int wave, int lane) {
    unsigned char* ws = A.ws;
    const int hh = it >> 7, ck = it & 127, q = lane >> 4, cc = lane & 15, col = 16 * wave + cc;
    const bf16* ST = (const bf16*)(ws + WS_ST) + ((size_t)it * 128 + col) * 128 + 8 * q; const bf16* UT = (const bf16*)(ws + WS_UNT) + ((size_t)it * 128 + col) * 64 + 8 * q;
    const bf16* qd = (const bf16*)(ws + WS_CQD) + (size_t)it * 8192 + cc * 128 + 8 * q; const bf16* at = (const bf16*)(ws + WS_CAT) + (size_t)it * 4096 + cc * 64 + 8 * q;
    const bf16* z = (const bf16*)(ws + WS_PROJ) + (size_t)(ck * 64) * INP + OFF_Z + hh * 128 + col; bf16* mix = (bf16*)(ws + WS_XB) + (size_t)(ck * 64) * DM + 2048 + hh * 128 + col;
    bf16x8 Sb[4], Ub[2], qf[4][4], af[4][2]; unsigned short zz[4][4];
#pragma unroll
    for (int s = 0; s < 4; ++s) Sb[s] = *(const bf16x8*)(ST + 32 * s);
    Ub[0] = *(const bf16x8*)UT; Ub[1] = *(const bf16x8*)(UT + 32);
#pragma unroll
    for (int mt = 0; mt < 4; ++mt) {
#pragma unroll
        for (int s = 0; s < 4; ++s) qf[mt][s] = *(const bf16x8*)(qd + mt * 2048 + 32 * s);
#pragma unroll
        for (int s = 0; s < 2; ++s) if (s <= (mt >> 1)) af[mt][s] = *(const bf16x8*)(at + mt * 1024 + 32 * s); }
#pragma unroll
    for (int mt = 0; mt < 4; ++mt)
#pragma unroll
        for (int r = 0; r < 4; ++r) zz[mt][r] = z[(size_t)(16 * mt + 4 * q + r) * INP];
    const float nw = A.in[I_NORMW][col];
    __builtin_amdgcn_sched_barrier(0);
    f32x4 O[4];
#pragma unroll
    for (int mt = 0; mt < 4; ++mt) { O[mt] = (f32x4){0.f, 0.f, 0.f, 0.f};
#pragma unroll
        for (int s = 0; s < 4; ++s) O[mt] = MFMA16(qf[mt][s], Sb[s], O[mt]);
#pragma unroll
        for (int s = 0; s < 2; ++s) if (s <= (mt >> 1)) O[mt] = MFMA16(af[mt][s], Ub[s], O[mt]); }
    LAS float* SSQ = (LAS float*)lds;
#pragma unroll
    for (int mt = 0; mt < 4; ++mt)
#pragma unroll
        for (int r = 0; r < 4; ++r) { const float ss = row16_sum(O[mt][r] * O[mt][r]); if (cc == 0) SSQ[(16 * mt + 4 * q + r) * 8 + wave] = ss; }
    __syncthreads();
#pragma unroll
    for (int mt = 0; mt < 4; ++mt)
#pragma unroll
        for (int r = 0; r < 4; ++r) { const int t = 16 * mt + 4 * q + r; const f32x4 a = *(const LAS f32x4*)(SSQ + t * 8), b = *(const LAS f32x4*)(SSQ + t * 8 + 4);
            const float ss = ((a[0] + a[1]) + (a[2] + a[3])) + ((b[0] + b[1]) + (b[2] + b[3])); const float rn = 1.0f / sqrtf(ss * (1.0f / 128.0f) + RMS_EPS);
            mix[(size_t)t * DM] = (bf16)f2bf(O[mt][r] * rn * nw * silu_acc(bf2f(zz[mt][r]))); }
    __syncthreads();
}

DI void ln_row(const float* src, int nslab, const float* g, const float* b, float* dstf, bf16* dstb, int lane) {
    const f32x4* xr = (const f32x4*)src + lane;
    f32x4 v[16]; float s = 0.f;
#pragma unroll
    for (int j = 0; j < 16; ++j) v[j] = xr[64 * j];

    for (int k = 1; k < nslab; ++k) { const f32x4* xk = xr + (size_t)k * (128 * DM / 4);
#pragma unroll
        for (int j = 0; j < 16; ++j) v[j] += xk[64 * j]; }
#pragma unroll
    for (int j = 0; j < 16; ++j) s += (v[j][0] + v[j][1]) + (v[j][2] + v[j][3]);
    const float mean = wave_sum(s) * (1.0f / DM); float s2 = 0.f;
#pragma unroll
    for (int j = 0; j < 16; ++j) { v[j] = v[j] - mean; s2 += (v[j][0] * v[j][0] + v[j][1] * v[j][1]) + (v[j][2] * v[j][2] + v[j][3] * v[j][3]); }
    const float rstd = 1.0f / sqrtf(wave_sum(s2) * (1.0f / DM) + LN_EPS);
    const f32x4* g4 = (const f32x4*)g + lane; const f32x4* b4 = (const f32x4*)b + lane;
#pragma unroll
    for (int j = 0; j < 16; ++j) { const f32x4 y = v[j] * rstd * g4[64 * j] + b4[64 * j];
        if (dstf) __builtin_nontemporal_store(y, (f32x4*)dstf + lane + 64 * j);
        if (dstb) { v2u w; w.x = cvtpk(y[0], y[1]); w.y = cvtpk(y[2], y[3]); ((v2u*)dstb + lane)[64 * j] = w; } }
}

DI void ln_row_wg(const float* src, int nslab, const float* g, const float* b, float* dstf, bf16* dstb, LAS unsigned char* lds, int tid, int wave, int lane) {
    LAS float* RED = (LAS float*)lds;
    const f32x4* xr = (const f32x4*)src + 2 * tid;
    f32x4 v0 = xr[0], v1 = xr[1];
#pragma unroll 4
    for (int k = 1; k < nslab; ++k) { const f32x4* xk = xr + (size_t)k * (128 * DM / 4); v0 += xk[0]; v1 += xk[1]; }
    float s = wave_sum((v0[0] + v0[1]) + (v0[2] + v0[3]) + (v1[0] + v1[1]) + (v1[2] + v1[3]));
    if (lane == 0) RED[wave] = s;
    __syncthreads();
    const float mean = (((RED[0] + RED[1]) + (RED[2] + RED[3])) + ((RED[4] + RED[5]) + (RED[6] + RED[7]))) * (1.0f / DM);
    v0 = v0 - mean; v1 = v1 - mean;
    float s2 = wave_sum((v0[0] * v0[0] + v0[1] * v0[1]) + (v0[2] * v0[2] + v0[3] * v0[3]) + (v1[0] * v1[0] + v1[1] * v1[1]) + (v1[2] * v1[2] + v1[3] * v1[3]));
    if (lane == 0) RED[8 + wave] = s2;
    __syncthreads();
    const float rstd = 1.0f / sqrtf((((RED[8] + RED[9]) + (RED[10] + RED[11])) + ((RED[12] + RED[13]) + (RED[14] + RED[15]))) * (1.0f / DM) + LN_EPS);
    const f32x4* g4 = (const f32x4*)g + 2 * tid; const f32x4* b4 = (const f32x4*)b + 2 * tid;
    const f32x4 y0 = v0 * rstd * g4[0] + b4[0], y1 = v1 * rstd * g4[1] + b4[1];
    if (dstf) { ((f32x4*)dstf)[2 * tid] = y0; ((f32x4*)dstf)[2 * tid + 1] = y1; }
    if (dstb) { v4u w; w.x = cvtpk(y0[0], y0[1]); w.y = cvtpk(y0[2], y0[3]); w.z = cvtpk(y1[0], y1[1]); w.w = cvtpk(y1[2], y1[3]); ((v4u*)dstb)[tid] = w; }
    __syncthreads();
}

DI void ln_row_b(const bf16* src, const float* g, const float* b, float* dstf, bf16* dstb, int lane) {
    const v2u* xr = (const v2u*)src + lane;
    f32x4 v[16]; float s = 0.f;
#pragma unroll
    for (int j = 0; j < 16; ++j) { const v2u w = xr[64 * j]; v[j] = (f32x4){bflo(w.x), bfhi(w.x), bflo(w.y), bfhi(w.y)}; s += (v[j][0] + v[j][1]) + (v[j][2] + v[j][3]); }
    const float mean = wave_sum(s) * (1.0f / DM); float s2 = 0.f;
#pragma unroll
    for (int j = 0; j < 16; ++j) { v[j] = v[j] - mean; s2 += (v[j][0] * v[j][0] + v[j][1] * v[j][1]) + (v[j][2] * v[j][2] + v[j][3] * v[j][3]); }
    const float rstd = 1.0f / sqrtf(wave_sum(s2) * (1.0f / DM) + LN_EPS);
    const f32x4* g4 = (const f32x4*)g + lane; const f32x4* b4 = (const f32x4*)b + lane;
#pragma unroll
    for (int j = 0; j < 16; ++j) { const f32x4 y = v[j] * rstd * g4[64 * j] + b4[64 * j];
        if (dstf) __builtin_nontemporal_store(y, (f32x4*)dstf + lane + 64 * j);
        if (dstb) { v2u w; w.x = cvtpk(y[0], y[1]); w.y = cvtpk(y[2], y[3]); ((v2u*)dstb + lane)[64 * j] = w; } }
}

constexpr int N_PHASES = 11;
constexpr int KSPLIT = 16;
constexpr int NSCAN = 16 * 8 / SCAN_NCW;

__global__ void __launch_bounds__(NTHR, 2) fwd(Args args) {
    extern __shared__ __attribute__((aligned(16))) unsigned char lds_raw[];
    LAS unsigned char* lds = (LAS unsigned char*)lds_raw;
    volatile LAS unsigned* MISC = (volatile LAS unsigned*)(lds + MISC_OFF);
    const int tid = threadIdx.x, lane = tid & 63, wave = __builtin_amdgcn_readfirstlane(tid >> 6);
    const int G = gridDim.x, bx = blockIdx.x, gw = bx * NWAVES + wave, NGW = G * NWAVES;
    unsigned char* ws = args.ws;
    gu32* ctl = (gu32*)(ws + WS_CTL);
    for (int u = tid; u < (LDS_BYTES - LDSCTL_OFF) / 4; u += NTHR) ((LAS unsigned*)(lds + LDSCTL_OFF))[u] = 0u;
    __syncthreads();
    const XcdBarrier bar = xcd_barrier_post((unsigned*)(ctl + CW_BAR) + args.li * XCD_BAR_WORDS, MISC + 8);
#define GRID_BAR() xcd_barrier(bar)
    const int lo = args.ph_lo, hi = args.ph_hi;
#define IN(k) (lo <= (k) && (k) < hi)
#define BOTH(k) (IN(k) && IN((k) + 1))

    if (IN(0)) { p0_prologue(args, lds, gw, NGW, wave, lane); if (BOTH(0)) GRID_BAR(); }

    if (IN(1)) {
        pg8::Gemm g{(const pg8::bf16_t*)(ws + WS_XB), (const pg8::bf16_t*)(ws + WS_WIN), MPAD, INP, DM}; pg8::StaticOrder S; S.init(MPAD, INP, DM, G, bx);
        pg8::EpiProj E{(pg8::bf16_t*)(ws + WS_PROJ), INP, (const float*)(ws + WS_BIASP), (float*)(ws + WS_AB), OFF_AB / 256};
        pg8::gemm_phase<pg8::EpiProj, pg8::StaticOrder, true, true>(lds + RING_OFF, g, S, E);
        __syncthreads();
        cv_pull3(args, lds, ctl + CW_QCV + 64 * args.li, 0, CV_T_OUT, wave, lane);
        if (BOTH(1)) GRID_BAR();
    }

    if (IN(3)) {
        for (int it = gw; it < MROWS + 128 * 12; it += NGW) {
            if (it < MROWS) p2_token(args, it, lane);
            else { const int j = it - MROWS; p2_convs(args, j / 12, j % 12, lane); } }
        __syncthreads();
        for (int it = 2 * bx; it < NITEM; it += 2 * G) p3_pair(args, it, lds, tid, wave, lane);
        if (BOTH(3)) GRID_BAR();
    }

    if (IN(4)) {
        const int msk = args.pad;
        if (bx < NSCAN) { if (msk & 1) p4_scan_wg(args, (NSCAN % 8 == 0) ? (bx % 8) * (NSCAN / 8) + bx / 8 : bx, lds, wave, lane); }
        else {
            const int ob = bx - NSCAN, NOB = G - NSCAN;
            if (NOB == 192) {
                const bool grpA = ob < 128;
                if (msk & 2) { for (int k = 0; k < 5; ++k) p4_sdn_pair(args, ob + 192 * k, lds, tid, lane); if (!grpA) p4_sdn_pair(args, 960 + (ob - 128), lds, tid, lane); }
                if (grpA) { if (msk & 4) p4_sattn(args, ob * NWAVES + wave, lane);
                    if (msk & 8) for (int k = 0; k < 4; ++k) p4_attn(args, ob * NWAVES + wave + 1024 * k, lane); }
                else { if (msk & 8) for (int k = 0; k < 8; ++k) p4_attn(args, 4096 + (ob - 128) * NWAVES + wave + 512 * k, lane); }
            } else {
                if (msk & 2) for (int p = ob; p < 1024; p += NOB) p4_sdn_pair(args, p, lds, tid, lane);
                if (msk & 4) for (int it = ob * NWAVES + wave; it < 1024; it += NOB * NWAVES) p4_sattn(args, it, lane);
                if (msk & 8) for (int it = ob * NWAVES + wave; it < 256 * 32; it += NOB * NWAVES) p4_attn(args, it, lane);
            }
        }
        if (BOTH(4)) GRID_BAR();
    }

    if (IN(5)) {
        for (int it = bx; it < NITEM; it += G) p5_item(args, it, lds, wave, lane);
        if (BOTH(5)) GRID_BAR();
    }

    if (IN(6)) {
        pg8::Gemm g{(const pg8::bf16_t*)(ws + WS_XB), (const pg8::bf16_t*)(ws + WS_WOUT), MPAD, DM, DM}; pg8::SplitTailOrder S; S.init(TP, DM, DM, (args.pad & 128) ? -1 : KSPLIT, G, bx);
        float* t1 = (float*)(ws + WS_PROJ);
        pg8::EpiRes E{args.in[I_XP], args.in[I_XS], t1, (float*)(ws + WS_SLAB), TP, MROWS, DM, TP / 256, ALPHA, nullptr, (pg8::bf16_t*)(ws + WS_PROJ)};
        pg8::gemm_phase<pg8::EpiRes, pg8::SplitTailOrder, true, true>(lds + RING_OFF, g, S, E);
        if (BOTH(6)) GRID_BAR();
    }

    if (IN(7)) {
        float* t1 = (float*)(ws + WS_PROJ);
        for (int r = TP + bx; r < MROWS; r += G) ln_row_wg((const float*)(ws + WS_SLAB) + (size_t)(r - TP) * DM, KSPLIT, args.in[I_LN1G], args.in[I_LN1B], nullptr, (bf16*)(ws + WS_XB) + (size_t)r * DM, lds, tid, wave, lane);
        for (int r = gw; r < TP; r += NGW) ln_row_b((const bf16*)(ws + WS_PROJ) + (size_t)r * DM, args.in[I_LN1G], args.in[I_LN1B], nullptr, (bf16*)(ws + WS_XB) + (size_t)r * DM, lane);
        if (BOTH(7)) GRID_BAR();
    }

    if (IN(8)) {
        pg8::Gemm g{(const pg8::bf16_t*)(ws + WS_XB), (const pg8::bf16_t*)(ws + WS_WGU), MPAD, NGU, DM}; pg8::StaticOrder S; S.init(MPAD, NGU, DM, G, bx);
        pg8::EpiSwiGLU E{(pg8::bf16_t*)(ws + WS_FFN), FF};
        pg8::gemm_phase<pg8::EpiSwiGLU, pg8::StaticOrder, true, true>(lds + RING_OFF, g, S, E);
        __syncthreads();
        cv_pull3(args, lds, ctl + CW_QCV + 256 + 64 * args.li, CV_T_OUT, CV_T3, wave, lane);
        if (BOTH(8)) GRID_BAR();
    }

    if (IN(9)) {
        pg8::Gemm g{(const pg8::bf16_t*)(ws + WS_FFN), (const pg8::bf16_t*)(ws + WS_WDN), MPAD, DM, FF}; pg8::SplitTailOrder S; S.init(TP, DM, FF, KSPLIT, G, bx);
        const float* h = (const float*)(ws + WS_PROJ);
        pg8::EpiRes E{h, h + (size_t)TP * DM, args.out + O_Y, (float*)(ws + WS_SLAB), TP, MROWS, DM, TP / 256, ALPHA, (const pg8::bf16_t*)(ws + WS_XB), (pg8::bf16_t*)(ws + WS_T2B)};
        pg8::gemm_phase<pg8::EpiRes, pg8::SplitTailOrder, true, true>(lds + RING_OFF, g, S, E);
        if (BOTH(9)) GRID_BAR();
    }

    if (IN(10)) {
        float* y = args.out + O_Y;
        for (int r = TP + bx; r < MROWS; r += G) ln_row_wg((const float*)(ws + WS_SLAB) + (size_t)(r - TP) * DM, KSPLIT, args.in[I_LN2G], args.in[I_LN2B], y + (size_t)r * DM, nullptr, lds, tid, wave, lane);
        for (int r = gw; r < TP; r += NGW) ln_row_b((const bf16*)(ws + WS_T2B) + (size_t)r * DM, args.in[I_LN2G], args.in[I_LN2B], y + (size_t)r * DM, nullptr, lane);
    }
#undef IN
#undef BOTH
#undef GRID_BAR
}

extern "C" void kernel_launch(void* const* d_in, const int* in_sizes, int n_in, void* d_out, int out_size, void* d_ws, size_t ws_size, hipStream_t stream) {
    static int grid = 0;
    if (grid == 0) {
        if (n_in != 21 || (size_t)out_size != O_END || ws_size < WS_END) { fprintf(stderr, "kernel_launch: unexpected problem (n_in %d, out %d, ws %zu); nothing launched\n", n_in, out_size, ws_size); grid = -1; return; }
        int dev = 0, cus = 0, per_cu = 0;
        if (hipGetDevice(&dev) != hipSuccess || hipDeviceGetAttribute(&cus, hipDeviceAttributeMultiprocessorCount, dev) != hipSuccess) { grid = -1; return; }
        if (hipFuncSetAttribute((const void*)fwd, hipFuncAttributeMaxDynamicSharedMemorySize, LDS_BYTES) != hipSuccess) { fprintf(stderr, "kernel_launch: hipFuncSetAttribute failed\n"); grid = -1; return; }
        if (hipOccupancyMaxActiveBlocksPerMultiprocessor(&per_cu, (const void*)fwd, NTHR, LDS_BYTES) != hipSuccess || per_cu < 1) { fprintf(stderr, "kernel_launch: occupancy query reports %d workgroups per CU\n", per_cu); }
        (void)hipGetLastError();
        grid = cus;
        if (grid < 2 * NSCAN) { fprintf(stderr, "kernel_launch: needs >= %d CUs, device has %d\n", 2 * NSCAN, cus); grid = -1; return; }
    }
    if (grid < 0) return;
    if (hipMemsetAsync((char*)d_ws + WS_CTL, 0, CTL_ZERO_BYTES, stream) != hipSuccess) return;
    Args a{};
    for (int i = 0; i < 21; ++i) a.in[i] = (const float*)d_in[i];
    a.out = (float*)d_out; a.ws = (unsigned char*)d_ws;
#if defined(PROBE_PHASE)
    const int nl = 3, los[3] = {0, PROBE_PHASE, PROBE_PHASE + 1}, his[3] = {PROBE_PHASE + 1, PROBE_PHASE + 1, N_PHASES};
#else
    const int nl = 1, los[1] = {0}, his[1] = {N_PHASES};
#endif
    for (int li = 0; li < nl; ++li) {
        if (los[li] >= his[li]) continue;
        a.ph_lo = los[li]; a.ph_hi = his[li]; a.li = li; a.pad = 15;
#if defined(PROBE_MASK)
        if (li == 1) a.pad = PROBE_MASK;
#endif
        hipLaunchKernelGGL(fwd, dim3(grid), dim3(NTHR), LDS_BYTES, stream, a);
        const hipError_t le = hipPeekAtLastError();
        if (le != hipSuccess) { fprintf(stderr, "kernel_launch: launch %d failed: %s\n", li, hipGetErrorName(le)); break; }
    }
}
```
